# Optimizing an MI355X kernel written in HIP

```python
import jax, jax.numpy as jnp
from jax import lax
import numpy as np

D_MODEL = 1024
BATCH = 16
SEQ = 2048
DEPTH = 1

MEM_LEN = 256
GLA_H = 4
GLA_QK = D_MODEL // 2
GLA_V = D_MODEL
GLA_DK = GLA_QK // GLA_H
GLA_DV = GLA_V // GLA_H
GLA_RANK = 16
GLA_TAU = 16.0
GLA_CHUNK = 64
SWA_HD = 64
SWA_HQ = D_MODEL // SWA_HD
SWA_HKV = 4
SWA_Q = SWA_HQ * SWA_HD
SWA_KV = SWA_HKV * SWA_HD
WINDOW = 128
ROPE_THETA = 10000.0
X_H = 4
X_HD = 256
X_W = X_H * X_HD
N_BRANCH = 3
IN_SIZES = (GLA_QK, GLA_QK, GLA_V, GLA_V, GLA_RANK,
            SWA_Q, SWA_KV, SWA_KV, SWA_Q,
            X_W, X_W,
            N_BRANCH * D_MODEL)
IN_COLS = sum(IN_SIZES)
EPS = 1e-6

kernel_name = "hybrid_gla_swa_sink_memxattn_gated"


def rmsnorm(x, g):
    xf = x.astype(jnp.float32)
    y = xf * lax.rsqrt(jnp.mean(xf * xf, axis=-1, keepdims=True) + EPS)
    return (y * g.astype(jnp.float32)).astype(x.dtype)


def rope(x, pos):
    half = x.shape[-1] // 2
    inv = ROPE_THETA ** (-jnp.arange(half, dtype=jnp.float32) / half)
    ang = pos.astype(jnp.float32)[:, None] * inv[None, :]
    cos = jnp.cos(ang)[None, :, None, :]
    sin = jnp.sin(ang)[None, :, None, :]
    xf = x.astype(jnp.float32)
    x1, x2 = xf[..., :half], xf[..., half:]
    out = jnp.concatenate([x1 * cos - x2 * sin, x2 * cos + x1 * sin], axis=-1)
    return out.astype(x.dtype)


def gla_chunked(q, k, v, log_a):
    B, S, H, DK = q.shape
    DV = v.shape[-1]
    C = GLA_CHUNK
    N = S // C

    def blk(t):
        return t.astype(jnp.float32).reshape(B, N, C, H, t.shape[-1]).transpose(0, 3, 1, 2, 4)

    qf = blk(q) * (DK ** -0.5)
    kf = blk(k)
    vf = blk(v)
    b = jnp.cumsum(blk(log_a), axis=3)
    b_last = b[:, :, :, -1:, :]
    q_dec = qf * jnp.exp(b)
    att = jnp.einsum('bhncd,bhnjd->bhncj', q_dec, kf * jnp.exp(-b))
    causal = jnp.tril(jnp.ones((C, C), dtype=bool))
    att = jnp.where(causal, att, 0.0)
    o_intra = jnp.einsum('bhncj,bhnjv->bhncv', att, vf)
    k_dec = kf * jnp.exp(b_last - b)
    chunk_decay = jnp.exp(b_last[:, :, :, 0, :])

    def step(state, inp):
        q_c, k_c, v_c, d_c = inp
        o_c = jnp.einsum('bhcd,bhdv->bhcv', q_c, state)
        state = d_c[..., None] * state + jnp.einsum('bhcd,bhcv->bhdv', k_c, v_c)
        return state, o_c

    xs = (jnp.moveaxis(q_dec, 2, 0), jnp.moveaxis(k_dec, 2, 0),
          jnp.moveaxis(vf, 2, 0), jnp.moveaxis(chunk_decay, 2, 0))
    _, o_inter = lax.scan(step, jnp.zeros((B, H, DK, DV), jnp.float32), xs)
    o = o_intra + jnp.moveaxis(o_inter, 0, 2)
    return o.transpose(0, 2, 3, 1, 4).reshape(B, S, H, DV)


def swa_sinks(q, k, v, sinks):
    B, S, HQ, D = q.shape
    HKV = k.shape[2]
    G = HQ // HKV
    W = WINDOW
    N = S // W
    qb = q.astype(jnp.float32).reshape(B, N, W, HKV, G, D)
    kb = k.astype(jnp.float32).reshape(B, N, W, HKV, D)
    vb = v.astype(jnp.float32).reshape(B, N, W, HKV, D)
    pad = ((0, 0), (1, 0), (0, 0), (0, 0), (0, 0))
    kk = jnp.concatenate([jnp.pad(kb, pad)[:, :N], kb], axis=2)
    vv = jnp.concatenate([jnp.pad(vb, pad)[:, :N], vb], axis=2)
    s = jnp.einsum('bnqhgd,bnkhd->bnhgqk', qb, kk) * (D ** -0.5)
    qi = jnp.arange(W)[:, None] + W
    kj = jnp.arange(2 * W)[None, :]
    band = (kj <= qi) & (kj > qi - W)
    has_prev = (jnp.arange(N) > 0)[:, None, None]
    valid = band[None] & (has_prev | (kj >= W)[None])
    s = jnp.where(valid[None, :, None, None], s, -jnp.inf)
    sink = sinks.astype(jnp.float32).reshape(1, 1, HKV, G, 1, 1)
    m = jnp.maximum(jnp.max(s, axis=-1, keepdims=True), sink)
    p = jnp.exp(s - m)
    p = p / (jnp.sum(p, axis=-1, keepdims=True) + jnp.exp(sink - m))
    o = jnp.einsum('bnhgqk,bnkhd->bnqhgd', p, vv)
    return o.reshape(B, S, HQ, D)


def setup_inputs(seed: int = 0) -> dict:
    key = jax.random.key(seed)
    ks = jax.random.split(key, 16)
    L = DEPTH

    def nrm(k, shape, scale):
        return jax.random.normal(k, shape, jnp.float32) * scale

    return {
        "x": nrm(ks[0], (BATCH, SEQ, D_MODEL), 1.0),
        "mem": nrm(ks[1], (BATCH, MEM_LEN, D_MODEL), 1.0),
        "g_mix": 1.0 + nrm(ks[2], (L, D_MODEL), 0.02),
        "g_mem": 1.0 + nrm(ks[3], (L, D_MODEL), 0.02),
        "w_in": nrm(ks[4], (L, D_MODEL, IN_COLS), D_MODEL ** -0.5),
        "b_in": nrm(ks[5], (L, IN_COLS), 0.01),
        "w_gla_gate_up": nrm(ks[6], (L, GLA_RANK, GLA_QK), GLA_RANK ** -0.5),
        "b_gla_gate": nrm(ks[7], (L, GLA_QK), 0.1),
        "g_gla_norm": 1.0 + nrm(ks[8], (L, GLA_DV), 0.02),
        "sinks": nrm(ks[9], (L, SWA_HQ), 0.5),
        "w_mem_kv": nrm(ks[10], (L, D_MODEL, 2 * X_W), D_MODEL ** -0.5),
        "w_br_gla": nrm(ks[11], (L, GLA_V, D_MODEL), GLA_V ** -0.5),
        "w_br_swa": nrm(ks[12], (L, SWA_Q, D_MODEL), SWA_Q ** -0.5),
        "w_br_mem": nrm(ks[13], (L, X_W, D_MODEL), X_W ** -0.5),
        "w_out": nrm(ks[14], (L, D_MODEL, D_MODEL), D_MODEL ** -0.5),
        "g_final": 1.0 + nrm(ks[15], (D_MODEL,), 0.02),
    }


def reference(x, mem, g_mix, g_mem, w_in, b_in, w_gla_gate_up, b_gla_gate, g_gla_norm, sinks,
              w_mem_kv, w_br_gla, w_br_swa, w_br_mem, w_out, g_final):
    B, S, _ = x.shape
    M = mem.shape[1]
    dt = x.dtype
    pos = jnp.arange(S)
    split_idx = tuple(int(i) for i in np.cumsum(IN_SIZES)[:-1])
    for l in range(DEPTH):
        h = rmsnorm(x, g_mix[l])
        proj = h @ w_in[l] + b_in[l]
        (gq, gk, gv, gz, glr, sq, sk, sv, sz, xq, xz, gates) = jnp.split(proj, split_idx, axis=-1)

        log_a = jax.nn.log_sigmoid((glr @ w_gla_gate_up[l] + b_gla_gate[l]).astype(jnp.float32)) / GLA_TAU
        o_a = gla_chunked(gq.reshape(B, S, GLA_H, GLA_DK), gk.reshape(B, S, GLA_H, GLA_DK),
                          gv.reshape(B, S, GLA_H, GLA_DV), log_a.reshape(B, S, GLA_H, GLA_DK))
        o_a = rmsnorm(o_a, g_gla_norm[l]).reshape(B, S, GLA_V).astype(dt)
        y_a = (o_a * jax.nn.silu(gz)) @ w_br_gla[l]

        q_b = rope(sq.reshape(B, S, SWA_HQ, SWA_HD), pos)
        k_b = rope(sk.reshape(B, S, SWA_HKV, SWA_HD), pos)
        o_b = swa_sinks(q_b, k_b, sv.reshape(B, S, SWA_HKV, SWA_HD), sinks[l])
        y_b = (o_b.reshape(B, S, SWA_Q).astype(dt) * jax.nn.silu(sz)) @ w_br_swa[l]

        mkv = rmsnorm(mem, g_mem[l]) @ w_mem_kv[l]
        mk = mkv[..., :X_W].reshape(B, M, X_H, X_HD).astype(jnp.float32)
        mv = mkv[..., X_W:].reshape(B, M, X_H, X_HD).astype(jnp.float32)
        s_c = jnp.einsum('bshd,bmhd->bhsm', xq.reshape(B, S, X_H, X_HD).astype(jnp.float32), mk) * (X_HD ** -0.5)
        p_c = jax.nn.softmax(s_c, axis=-1)
        o_c = jnp.einsum('bhsm,bmhd->bshd', p_c, mv).reshape(B, S, X_W).astype(dt)
        y_c = (o_c * jax.nn.silu(xz)) @ w_br_mem[l]

        g = jax.nn.sigmoid(gates.astype(jnp.float32)).reshape(B, S, N_BRANCH, D_MODEL)
        merged = (g[:, :, 0] * y_a.astype(jnp.float32) + g[:, :, 1] * y_b.astype(jnp.float32)
                  + g[:, :, 2] * y_c.astype(jnp.float32)).astype(dt)
        x = x + merged @ w_out[l]
    return rmsnorm(x, g_final)
```

```cpp
#include <hip/hip_runtime.h>
#include <cstdio>
#include <cstdint>
namespace pg8 {
#define PG8_LAS __attribute__((address_space(3)))
typedef unsigned short bf16_t;
typedef short bf16x8 __attribute__((ext_vector_type(8)));
typedef float f32x4 __attribute__((ext_vector_type(4)));
typedef unsigned u32x4 __attribute__((ext_vector_type(4)));
constexpr int BM = 256, BK = 64, HALF = 128, HTB = HALF * BK * 2  , STAGE_BYTES = 8 * HTB, NXCD = 8, WGM = 8;

__host__ __device__ __forceinline__ int lds_byte(int r, int c) { const int st = (r >> 4) * 2 + (c >> 5), rr = r & 15, cc = c & 31, ob = rr * 64 + cc * 2; return st * 1024 + (ob ^ (((ob >> 9) & 1) << 5)); }
__host__ __device__ __forceinline__ void stage_rc(int b, int& R, int& C) { const int st = b / 1024, sb = b % 1024, swz = sb ^ (((sb >> 9) & 1) << 5); R = (st >> 1) * 16 + swz / 64; C = (st & 1) * 32 + (swz % 64) / 2; }
__host__ __device__ __forceinline__ int perm32(int rho) { const int n = rho >> 4, i = rho & 15; return 8 * (i >> 2) + 4 * n + (i & 3); }

struct Unit { int pm, pn; };
struct Gemm { const bf16_t* A; const bf16_t* Bt; int lda, ldb, K; };


struct RectOrder {
    int nM, nN, pn0, nwg1, nM2, pm2, pn2, nwg, G, c;
    __device__ void init(int nM_, int nN_, int pn0_, int nM2_, int nN2_, int pm2_, int pn2_, int G_, int c_) {
        nM = nM_; nN = nN_; pn0 = pn0_; nwg1 = nM_ * nN_; nM2 = nM2_ > 0 ? nM2_ : 1; pm2 = pm2_; pn2 = pn2_; nwg = nwg1 + nM2_ * nN2_; G = G_; c = c_; }
    __device__ bool next(int i, Unit& u) const {
        const long L = (long)i * G + c; if (L >= nwg) return false;
        if (L < nwg1) {
            int wgid = (int)L; { const int q = nwg1 / NXCD, r = nwg1 % NXCD, xcd = wgid % NXCD, off = wgid / NXCD; wgid = (xcd < r ? xcd * (q + 1) : r * (q + 1) + (xcd - r) * q) + off; }
            const int nig = WGM * nN, gid = wgid / nig, fm = gid * WGM, gsz = (nM - fm) < WGM ? (nM - fm) : WGM;
            u.pm = fm + ((wgid % nig) % gsz); u.pn = pn0 + (wgid % nig) / gsz;
        } else { const int r = (int)L - nwg1; u.pm = pm2 + r % nM2; u.pn = pn2 + r / nM2; }
        return true;
    }
    __device__ __forceinline__ void a_ready(const Unit&) const {}
    __device__ __forceinline__ void done(const Unit&) const {}
};

__device__ __forceinline__ unsigned cvt_pk_bf16(float lo, float hi) { unsigned r; asm volatile("v_cvt_pk_bf16_f32 %0, %1, %2" : "=v"(r) : "v"(lo), "v"(hi)); return r; }
__device__ __forceinline__ float bflo(unsigned w) { return __builtin_bit_cast(float, w << 16); }
__device__ __forceinline__ float bfhi(unsigned w) { return __builtin_bit_cast(float, w & 0xffff0000u); }
__device__ __forceinline__ float sigm(float v) { return __builtin_amdgcn_rcpf(1.f + __expf(-v)); }

struct EpiProj {
    static constexpr bool PERM = true, AFTER_DRAIN = false;
    const float* rstd; const float* bias; float* glr;
    bf16_t *GQ, *GK, *GV, *Z, *SQ, *SK, *SV, *XQ, *GATES, *MKV;
    __device__ __forceinline__ void operator()(const f32x4 (&acc)[2][2][4][2], const Unit& u, int wr, int wc, int fr, int fq) const {
        const int pn = u.pn; bf16_t* base; int ld, ct, act = 0, rowoff = 0;
        if (pn < 2) { base = GQ; ld = 512; ct = pn; }
        else if (pn < 4) { base = GK; ld = 512; ct = pn - 2; }
        else if (pn < 8) { base = GV; ld = 1024; ct = pn - 4; }
        else if (pn < 12) { base = Z; ld = 3072; ct = pn - 8; act = 1; }
        else if (pn < 16) { base = SQ; ld = 1024; ct = pn - 12; }
        else if (pn == 16) { base = SK; ld = 256; ct = 0; }
        else if (pn == 17) { base = SV; ld = 256; ct = 0; }
        else if (pn < 22) { base = Z + 1024; ld = 3072; ct = pn - 18; act = 1; }
        else if (pn < 26) { base = XQ; ld = 1024; ct = pn - 22; }
        else if (pn < 30) { base = Z + 2048; ld = 3072; ct = pn - 26; act = 1; }
        else if (pn == 30) { base = nullptr; ld = 16; ct = 0; act = 3; }
        else if (pn < 43) { base = GATES; ld = 3072; ct = pn - 31; act = 2; }
        else { base = MKV; ld = 2048; ct = pn - 43; rowoff = 32768; }
        const int row0 = u.pm * BM + wr * 64 + fr;
        const int colL = ct * BM + wc * 32 + 8 * fq, bcol0 = pn * BM + wc * 32 + 8 * fq;
        float rs[2][4];
#pragma unroll
        for (int ai = 0; ai < 2; ++ai)
#pragma unroll
            for (int m = 0; m < 4; ++m) rs[ai][m] = rstd[row0 + ai * HALF + m * 16];
        if (act == 3) {
            if (wc == 0 && fq < 2) {
                const f32x4 b0 = *(const f32x4*)(bias + bcol0), b1 = *(const f32x4*)(bias + bcol0 + 4);
#pragma unroll
                for (int ai = 0; ai < 2; ++ai)
#pragma unroll
                    for (int m = 0; m < 4; ++m) { float* rp = glr + (size_t)(row0 + ai * HALF + m * 16) * 16 + 8 * fq;
                        *(f32x4*)rp = acc[ai][0][m][0] * rs[ai][m] + b0; *(f32x4*)(rp + 4) = acc[ai][0][m][1] * rs[ai][m] + b1; }
            }
            return;
        }
        f32x4 bv[2][2];
#pragma unroll
        for (int bj = 0; bj < 2; ++bj)
#pragma unroll
            for (int n = 0; n < 2; ++n) bv[bj][n] = *(const f32x4*)(bias + bcol0 + bj * HALF + 4 * n);
#pragma unroll
        for (int ai = 0; ai < 2; ++ai)
#pragma unroll
            for (int m = 0; m < 4; ++m) { bf16_t* rowp = base + (size_t)(row0 - rowoff + ai * HALF + m * 16) * ld + colL;
#pragma unroll
                for (int bj = 0; bj < 2; ++bj) { f32x4 v0 = acc[ai][bj][m][0] * rs[ai][m] + bv[bj][0], v1 = acc[ai][bj][m][1] * rs[ai][m] + bv[bj][1];
                    if (act == 1) {
#pragma unroll
                        for (int e = 0; e < 4; ++e) { v0[e] = v0[e] * sigm(v0[e]); v1[e] = v1[e] * sigm(v1[e]); } }
                    else if (act == 2) {
#pragma unroll
                        for (int e = 0; e < 4; ++e) { v0[e] = sigm(v0[e]); v1[e] = sigm(v1[e]); } }
                    u32x4 w; w.x = cvt_pk_bf16(v0[0], v0[1]); w.y = cvt_pk_bf16(v0[2], v0[3]); w.z = cvt_pk_bf16(v1[0], v1[1]); w.w = cvt_pk_bf16(v1[2], v1[3]);
                    *(u32x4*)(rowp + bj * HALF) = w; } }
    }
};

struct EpiBranch {
    static constexpr bool PERM = true, AFTER_DRAIN = false;
    const bf16_t* GATES; bf16_t* MERGED; int j;
    __device__ __forceinline__ void operator()(const f32x4 (&acc)[2][2][4][2], const Unit& u, int wr, int wc, int fr, int fq) const {
        const int row0 = u.pm * BM + wr * 64 + fr, col0 = u.pn * BM + wc * 32 + 8 * fq;
#pragma unroll
        for (int ai = 0; ai < 2; ++ai)
#pragma unroll
            for (int m = 0; m < 4; ++m) { const size_t r = (size_t)(row0 + ai * HALF + m * 16);
#pragma unroll
                for (int bj = 0; bj < 2; ++bj) { const int c = col0 + bj * HALF;
                    const u32x4 g = *(const u32x4*)(GATES + r * 3072 + j * 1024 + c);
                    u32x4 o = (u32x4){0u, 0u, 0u, 0u}; if (j > 0) o = *(const u32x4*)(MERGED + r * 1024 + c);
                    const f32x4 a0 = acc[ai][bj][m][0], a1 = acc[ai][bj][m][1];
                    u32x4 w;
                    w.x = cvt_pk_bf16(bflo(o.x) + bflo(g.x) * a0[0], bfhi(o.x) + bfhi(g.x) * a0[1]);
                    w.y = cvt_pk_bf16(bflo(o.y) + bflo(g.y) * a0[2], bfhi(o.y) + bfhi(g.y) * a0[3]);
                    w.z = cvt_pk_bf16(bflo(o.z) + bflo(g.z) * a1[0], bfhi(o.z) + bfhi(g.z) * a1[1]);
                    w.w = cvt_pk_bf16(bflo(o.w) + bflo(g.w) * a1[2], bfhi(o.w) + bfhi(g.w) * a1[3]);
                    *(u32x4*)(MERGED + r * 1024 + c) = w; } }
    }
};

struct EpiOut {
    static constexpr bool PERM = false, AFTER_DRAIN = false;
    const float* x; float* out; float* rowss;
    __device__ __forceinline__ void operator()(const f32x4 (&acc)[2][2][4][2], const Unit& u, int wr, int wc, int fr, int fq) const {
        const int row0 = u.pm * BM + wr * 64 + fr, col0 = u.pn * BM + wc * 32 + 4 * fq;
#pragma unroll
        for (int ai = 0; ai < 2; ++ai)
#pragma unroll
            for (int m = 0; m < 4; ++m) { const size_t r = (size_t)(row0 + ai * HALF + m * 16); float s = 0.f;
#pragma unroll
                for (int bj = 0; bj < 2; ++bj)
#pragma unroll
                    for (int n = 0; n < 2; ++n) { const size_t off = r * 1024 + col0 + bj * HALF + n * 16;
                        const f32x4 y = *(const f32x4*)(x + off) + acc[ai][bj][m][n]; *(f32x4*)(out + off) = y;
                        s += (y[0] * y[0] + y[1] * y[1]) + (y[2] * y[2] + y[3] * y[3]); }
                s += __shfl_xor(s, 16); s += __shfl_xor(s, 32);
                if (fq == 0) atomicAdd(rowss + r, s); }
    }
};

template <class Epi, class Sched, bool ALIGN_EPI = false, bool SP2 = false>
__device__ __forceinline__ void gemm_phase(PG8_LAS unsigned char* lds, const Gemm g, const Sched& S, const Epi& E) {
    const int tid = threadIdx.x, wid = __builtin_amdgcn_readfirstlane(tid >> 6), lane = tid & 63, wr = wid >> 2, wc = wid & 3, fr = lane & 15, fq = lane >> 4;
    const int K = g.K, nt = K / BK;
    unsigned voffA[2], voffB[2];
#pragma unroll
    for (int i = 0; i < 2; ++i) { int R, C; stage_rc(tid * 16 + i * 8192, R, C); const int Rb = Epi::PERM ? ((R & ~31) + perm32(R & 31)) : R;
        voffA[i] = (unsigned)(R * g.lda + C) * 2u; voffB[i] = (unsigned)(Rb * g.ldb + C) * 2u; }
    const size_t kstep = (size_t)(BK * 2);
    const size_t hstepA = (size_t)HALF * g.lda * 2, hstepB = (size_t)HALF * g.ldb * 2;
    const size_t tstepA = 2 * hstepA, tstepB = 2 * hstepB;
    const unsigned ldsw = (unsigned)wid * 1024u;
    const int aoff = lds_byte(wr * 64 + fr, fq * 8), boff = lds_byte(wc * 32 + fr, fq * 8);
#define PG8_SA(b, h) (((b) * 2 + (h)) * HTB)
#define PG8_SB(b, h) ((4 + (b) * 2 + (h)) * HTB)
#define PG8_STAGE(bufoff, gbase, voff) do { _Pragma("unroll") for (int _i = 0; _i < 2; ++_i) \
        __builtin_amdgcn_global_load_lds((const unsigned*)((const char*)(gbase) + (voff)[_i]), (PG8_LAS unsigned*)(lds + (bufoff) + ldsw + _i * 8192), 16, 0, 0); } while (0)
#define PG8_LDA(dst, b, h) do { _Pragma("unroll") for (int m = 0; m < 4; ++m) _Pragma("unroll") for (int k = 0; k < 2; ++k) dst[m][k] = *(const PG8_LAS bf16x8*)(lds + PG8_SA(b, h) + aoff + m * 2048 + k * 1024); } while (0)
#define PG8_LDB(dst, b, h) do { _Pragma("unroll") for (int n = 0; n < 2; ++n) _Pragma("unroll") for (int k = 0; k < 2; ++k) dst[n][k] = *(const PG8_LAS bf16x8*)(lds + PG8_SB(b, h) + boff + n * 2048 + k * 1024); } while (0)
#define PG8_MMA(ai, bj, At, Bt) do { __builtin_amdgcn_s_setprio(1); _Pragma("unroll") for (int m = 0; m < 4; ++m) _Pragma("unroll") for (int n = 0; n < 2; ++n) _Pragma("unroll") for (int k = 0; k < 2; ++k) \
        acc[ai][bj][m][n] = __builtin_amdgcn_mfma_f32_16x16x32_bf16(Bt[n][k], At[m][k], acc[ai][bj][m][n], 0, 0, 0); __builtin_amdgcn_s_setprio(0); } while (0)
#define PG8_WAIT_V(n) asm volatile("s_waitcnt vmcnt(" #n ")" ::: "memory")
#define PG8_WAIT_L(n) asm volatile("s_waitcnt lgkmcnt(" #n ")" ::: "memory")
#define PG8_BAR __builtin_amdgcn_s_barrier()
#define PG8_SCHED __builtin_amdgcn_sched_barrier(0)
    Unit cur, nxt; int ui = 0;
    if (!S.next(0, cur)) return;
    f32x4 acc[2][2][4][2];
#pragma unroll
    for (int a = 0; a < 2; ++a)
#pragma unroll
        for (int b = 0; b < 2; ++b)
#pragma unroll
            for (int m = 0; m < 4; ++m)
#pragma unroll
                for (int n = 0; n < 2; ++n) acc[a][b][m][n] = (f32x4){0.f, 0.f, 0.f, 0.f};
    bf16x8 At[4][2], B0[2][2], B1[2][2];
    const char* cA = (const char*)g.A + (size_t)cur.pm * tstepA; const char* cB = (const char*)g.Bt + (size_t)cur.pn * tstepB;
    S.a_ready(cur);
    if constexpr (SP2) {
        PG8_STAGE(PG8_SB(0, 0), cB, voffB); PG8_STAGE(PG8_SB(0, 1), cB + hstepB, voffB); PG8_STAGE(PG8_SA(0, 0), cA, voffA); PG8_STAGE(PG8_SA(0, 1), cA + hstepA, voffA);
        if (wr == 1) PG8_BAR;
        PG8_WAIT_V(2); PG8_BAR;
        PG8_STAGE(PG8_SB(1, 0), cB + kstep, voffB); PG8_STAGE(PG8_SA(1, 0), cA + kstep, voffA); PG8_STAGE(PG8_SB(1, 1), cB + hstepB + kstep, voffB);
        PG8_WAIT_V(6); PG8_BAR;
    } else {
        PG8_STAGE(PG8_SB(0, 0), cB, voffB); PG8_STAGE(PG8_SA(0, 0), cA, voffA); PG8_STAGE(PG8_SB(0, 1), cB + hstepB, voffB); PG8_STAGE(PG8_SA(0, 1), cA + hstepA, voffA);
        if (wr == 1) PG8_BAR;
        PG8_WAIT_V(4); PG8_BAR;
        PG8_STAGE(PG8_SB(1, 0), cB + kstep, voffB); PG8_STAGE(PG8_SA(1, 0), cA + kstep, voffA); PG8_STAGE(PG8_SB(1, 1), cB + hstepB + kstep, voffB);
        PG8_WAIT_V(6); PG8_BAR;
    }
    for (;;) {
        const bool has_next = S.next(ui + 1, nxt);
        const char* nA = has_next ? (const char*)g.A + (size_t)nxt.pm * tstepA : cA; const char* nB = has_next ? (const char*)g.Bt + (size_t)nxt.pn * tstepB : cB;
        for (int t = 0; t < nt; t += 2) {
            const bool last = (t == nt - 2);
            const char* a1 = cA + (size_t)(t + 1) * kstep;
            const char* a2 = last ? nA : cA + (size_t)(t + 2) * kstep; const char* b2 = last ? nB : cB + (size_t)(t + 2) * kstep;
            const char* a3 = a2 + kstep; const char* b3 = b2 + kstep;
            if (last && has_next) S.a_ready(nxt);
            if constexpr (SP2) {
            PG8_LDB(B0, 0, 0); PG8_LDB(B1, 0, 1); PG8_SCHED; PG8_LDA(At, 0, 0); PG8_STAGE(PG8_SA(1, 1), a1 + hstepA, voffA);
            PG8_WAIT_V(8); PG8_WAIT_L(0); PG8_BAR; PG8_MMA(0, 0, At, B0); PG8_MMA(0, 1, At, B1); PG8_BAR; PG8_SCHED;
            PG8_LDA(At, 0, 1); PG8_STAGE(PG8_SB(0, 0), b2, voffB); PG8_STAGE(PG8_SB(0, 1), b2 + hstepB, voffB); PG8_STAGE(PG8_SA(0, 0), a2, voffA);
            PG8_WAIT_V(8); PG8_WAIT_L(0); PG8_BAR; PG8_MMA(1, 0, At, B0); PG8_MMA(1, 1, At, B1); PG8_BAR; PG8_SCHED;
            PG8_LDB(B0, 1, 0); PG8_LDB(B1, 1, 1); PG8_SCHED; PG8_LDA(At, 1, 0); PG8_STAGE(PG8_SA(0, 1), a2 + hstepA, voffA);
            PG8_WAIT_V(8); PG8_WAIT_L(0); PG8_BAR; PG8_MMA(0, 0, At, B0); PG8_MMA(0, 1, At, B1); PG8_BAR; PG8_SCHED;
            PG8_LDA(At, 1, 1); PG8_STAGE(PG8_SB(1, 0), b3, voffB); PG8_STAGE(PG8_SB(1, 1), b3 + hstepB, voffB); PG8_STAGE(PG8_SA(1, 0), a3, voffA);
            PG8_WAIT_V(8); PG8_WAIT_L(0); PG8_BAR; PG8_MMA(1, 0, At, B0); PG8_MMA(1, 1, At, B1); PG8_BAR; PG8_SCHED;
            } else {
            PG8_LDB(B0, 0, 0); PG8_SCHED; PG8_LDA(At, 0, 0); PG8_STAGE(PG8_SA(1, 1), a1 + hstepA, voffA);
            PG8_WAIT_L(8); PG8_BAR; PG8_WAIT_L(0); PG8_MMA(0, 0, At, B0); PG8_BAR; PG8_SCHED;
            PG8_LDB(B1, 0, 1); PG8_STAGE(PG8_SB(0, 0), b2, voffB);
            PG8_BAR; PG8_WAIT_L(0); PG8_MMA(0, 1, At, B1); PG8_BAR;
            PG8_LDA(At, 0, 1); PG8_STAGE(PG8_SA(0, 0), a2, voffA);
            PG8_BAR; PG8_WAIT_L(0); PG8_MMA(1, 0, At, B0); PG8_BAR; PG8_SCHED;
            PG8_STAGE(PG8_SB(0, 1), b2 + hstepB, voffB);
            PG8_WAIT_V(6); PG8_BAR; PG8_MMA(1, 1, At, B1); PG8_BAR;
            PG8_LDB(B0, 1, 0); PG8_SCHED; PG8_LDA(At, 1, 0); PG8_STAGE(PG8_SA(0, 1), a2 + hstepA, voffA);
            PG8_WAIT_L(8); PG8_BAR; PG8_WAIT_L(0); PG8_MMA(0, 0, At, B0); PG8_BAR; PG8_SCHED;
            PG8_LDB(B1, 1, 1); PG8_STAGE(PG8_SB(1, 0), b3, voffB);
            PG8_BAR; PG8_WAIT_L(0); PG8_MMA(0, 1, At, B1); PG8_BAR;
            PG8_LDA(At, 1, 1); PG8_STAGE(PG8_SA(1, 0), a3, voffA);
            PG8_BAR; PG8_WAIT_L(0); PG8_MMA(1, 0, At, B0); PG8_BAR; PG8_SCHED;
            PG8_STAGE(PG8_SB(1, 1), b3 + hstepB, voffB);
            PG8_WAIT_V(6); PG8_BAR; PG8_MMA(1, 1, At, B1); PG8_BAR;
            }
        }
        if constexpr (ALIGN_EPI) { if (wr == 0) PG8_BAR; }
        if constexpr (!Epi::AFTER_DRAIN) { E(acc, cur, wr, wc, fr, fq); S.done(cur); }
        if (!has_next) break;
#pragma unroll
        for (int a = 0; a < 2; ++a)
#pragma unroll
            for (int b = 0; b < 2; ++b)
#pragma unroll
                for (int m = 0; m < 4; ++m)
#pragma unroll
                    for (int n = 0; n < 2; ++n) acc[a][b][m][n] = (f32x4){0.f, 0.f, 0.f, 0.f};
        cur = nxt; cA = nA; cB = nB; ++ui;
        if constexpr (ALIGN_EPI) { if (wr == 1) PG8_BAR; }
    }
    PG8_WAIT_V(0);
    if constexpr (!ALIGN_EPI) { if (wr == 0) PG8_BAR; }
    PG8_BAR;
    if constexpr (Epi::AFTER_DRAIN) { E.fused(acc, cur, wr, wc, fr, fq, lds, wid, lane); S.done(cur); }
#undef PG8_SA
#undef PG8_SB
#undef PG8_STAGE
#undef PG8_LDA
#undef PG8_LDB
#undef PG8_MMA
#undef PG8_WAIT_V
#undef PG8_WAIT_L
#undef PG8_BAR
#undef PG8_SCHED
}
}
#define GAS __attribute__((address_space(1)))
#define LAS __attribute__((address_space(3)))
typedef unsigned short bf16;
typedef unsigned v4u __attribute__((ext_vector_type(4)));
typedef float f32x4 __attribute__((ext_vector_type(4)));
typedef short bf16x8 __attribute__((ext_vector_type(8)));
typedef GAS unsigned gu32;
typedef GAS unsigned long long gu64;
#define RLX_AGENT __ATOMIC_RELAXED, __HIP_MEMORY_SCOPE_AGENT
#define LDS_WAIT() asm volatile("s_waitcnt lgkmcnt(0)" ::: "memory")
#define VM_WAIT() asm volatile("s_waitcnt vmcnt(0)" ::: "memory")
__device__ __forceinline__ unsigned long long rt() { return __builtin_amdgcn_s_memrealtime(); }
__device__ __forceinline__ unsigned f2bf(float f) { unsigned u = __builtin_bit_cast(unsigned, f); return (u + 0x7fffu + ((u >> 16) & 1u)) >> 16; }
__device__ __forceinline__ unsigned pk2(float lo, float hi) { return f2bf(lo) | (f2bf(hi) << 16); }

#define XB_TMO      128
#define XB_XCNT(j)  (256  + 64 * (j))
#define XB_XSUB(j)  (1280 + 64 * (j))
#define XB_XGEN(j)  (2304 + 64 * (j))
#define XB_TOP      3328
#define XB_TOPGEN   3392
#define XCD_BAR_WORDS 3456
#define XB_SPIN_CAP (1u << 22)

__device__ __forceinline__ unsigned xb_ld(unsigned* p)              { return __hip_atomic_load(p, __ATOMIC_RELAXED, __HIP_MEMORY_SCOPE_AGENT); }
__device__ __forceinline__ unsigned xb_add(unsigned* p, unsigned v) { return __hip_atomic_fetch_add(p, v, __ATOMIC_RELAXED, __HIP_MEMORY_SCOPE_AGENT); }
__device__ __forceinline__ unsigned xb_xcc_id() { return (unsigned)__builtin_amdgcn_s_getreg((3 << 11) | 20) & 0xFu; }
#define XB_SPIN(cond, bar) do { unsigned _sp = 0; while (cond) { __builtin_amdgcn_s_sleep(1); \
    if ((++_sp & 255u) == 0u) { if (xb_ld(&(bar)[XB_TMO])) break; if (_sp > XB_SPIN_CAP) { atomicAdd(&(bar)[XB_TMO], 1u); break; } } } } while (0)

struct XcdBarrier {
    unsigned* bar; unsigned x;
    volatile LAS unsigned* st;
};

__device__ __forceinline__ XcdBarrier xcd_barrier_post(unsigned* bar, volatile LAS unsigned* st) {
    XcdBarrier b; b.bar = bar; b.x = xb_xcc_id(); b.st = st;
    if (threadIdx.x == 0) (void)xb_add(&bar[XB_XCNT(b.x)], 1u);
    return b;
}
__device__ __forceinline__ void xcd_barrier_complete(unsigned* bar, unsigned x, unsigned& nloc, unsigned& nx) {
    const unsigned G = gridDim.x * gridDim.y * gridDim.z;
    unsigned sum, cnt, mine, sp = 0u;
    for (;;) {
        sum = 0u; cnt = 0u; mine = 0u;
#pragma unroll
        for (unsigned j = 0; j < 16; ++j) { const unsigned c = xb_ld(&bar[XB_XCNT(j)]); sum += c; cnt += (c > 0u) ? 1u : 0u; mine = (j == x) ? c : mine; }
        if (sum == G) break;
        __builtin_amdgcn_s_sleep(1);
        if ((++sp & 255u) == 0u) { if (xb_ld(&bar[XB_TMO])) break; if (sp > XB_SPIN_CAP) { atomicAdd(&bar[XB_TMO], 1u); break; } }
    }
    nloc = mine > 0u ? mine : 1u; nx = cnt > 0u ? cnt : 1u;
}

__device__ __forceinline__ void xcd_barrier(const XcdBarrier& b) {
    asm volatile("s_waitcnt vmcnt(0)" ::: "memory");
    __syncthreads();
    if (threadIdx.x == 0) {
        unsigned* bar = b.bar;
        __builtin_amdgcn_s_waitcnt(0);
        unsigned nloc = b.st[0], nx = b.st[1];
        if (nloc == 0u) { xcd_barrier_complete(bar, b.x, nloc, nx); b.st[0] = nloc; b.st[1] = nx; }
        const unsigned old = xb_add(&bar[XB_XSUB(b.x)], 1u);
        const unsigned gen = old / nloc;
        if (old + 1u == (gen + 1u) * nloc) {
            __builtin_amdgcn_fence(__ATOMIC_RELEASE, "agent");
            asm volatile("s_waitcnt vmcnt(0)" ::: "memory");
            const unsigned og = xb_add(&bar[XB_TOP], 1u);
            const unsigned tg = og / nx;
            if (og + 1u == (tg + 1u) * nx) xb_add(&bar[XB_TOPGEN], 1u);
            else XB_SPIN(xb_ld(&bar[XB_TOPGEN]) == tg, bar);
            __builtin_amdgcn_fence(__ATOMIC_ACQUIRE, "agent");
            xb_add(&bar[XB_XGEN(b.x)], 1u);
            asm volatile("s_waitcnt vmcnt(0)" ::: "memory");
        } else {
            XB_SPIN(xb_ld(&bar[XB_XGEN(b.x)]) == gen, bar);
            __builtin_amdgcn_fence(__ATOMIC_ACQUIRE, "agent");
            asm volatile("s_waitcnt vmcnt(0)" ::: "memory");
        }
    }
    __syncthreads();
}

constexpr int NWAVES = 8;
constexpr int BATCH = 16, SEQ = 2048, DM = 1024, T = BATCH * SEQ, MEM = 256, TM = BATCH * MEM;
constexpr int INC = 10768;
constexpr int NT1 = 31, NTG = 12, NTKV = 8;
constexpr int WT_ROWS = (NT1 + NTG + NTKV) * 256;
constexpr float EPS = 1e-6f;
#ifndef MK_N_LAUNCHES
#define MK_N_LAUNCHES 1
#endif
constexpr int N_PHASES = 9;
constexpr int N_LAUNCHES = MK_N_LAUNCHES;

constexpr size_t MiB = 1u << 20;
constexpr size_t WS_CTL = 0, CTL_ZERO_BYTES = 1 * MiB;
constexpr size_t CTL_ROWSS = 512 * 1024;
constexpr size_t WS_WT = 2 * MiB;
constexpr size_t WS_WBR = 28 * MiB;
constexpr size_t WS_WOUT = 34 * MiB;
constexpr size_t WS_RSTD = 36 * MiB;
constexpr size_t WS_BIAS = 36 * MiB + 256 * 1024;
constexpr size_t WS_COS = 36 * MiB + 512 * 1024, WS_SIN = 36 * MiB + 768 * 1024;
constexpr size_t WS_GLR = 37 * MiB;
constexpr size_t WS_Z = 40 * MiB;
constexpr size_t WS_GQ = 232 * MiB, WS_GK = 264 * MiB, WS_GV = 296 * MiB, WS_SQ = 360 * MiB, WS_XQ = 424 * MiB;
constexpr size_t WS_GATES = 232 * MiB, WS_MERGED = 424 * MiB;
constexpr size_t WS_END = 488 * MiB;
constexpr size_t DO_XB = 0, DO_SK = 72 * MiB, DO_SV = 88 * MiB, DO_MKV = 104 * MiB;
constexpr int CW_BAR = 4096;

constexpr int LDS_BYTES = 159744;
constexpr int MISC_OFF = 158720;

__device__ __forceinline__ float bf2f(bf16 h) { return __builtin_bit_cast(float, (unsigned)h << 16); }
__device__ __forceinline__ float wave_sum(float v) {
#pragma unroll
    for (int o = 1; o < 64; o <<= 1) v += __shfl_xor(v, o);
    return v;
}
__device__ __forceinline__ float wave_max(float v) {
#pragma unroll
    for (int o = 1; o < 64; o <<= 1) v = fmaxf(v, __shfl_xor(v, o));
    return v;
}
__device__ const double INVF[32] = {1.0, 0.7498942093324559, 0.5623413251903491, 0.4216965034285822, 0.31622776601683794, 0.23713737056616552, 0.1778279410038923, 0.1333521432163324, 0.1, 0.07498942093324558,
    0.05623413251903491, 0.042169650342858224, 0.03162277660168379, 0.023713737056616554, 0.01778279410038923, 0.01333521432163324, 0.01, 0.007498942093324558, 0.005623413251903491, 0.004216965034285823,
    0.0031622776601683794, 0.0023713737056616554, 0.0017782794100389228, 0.001333521432163324, 0.001, 0.0007498942093324559, 0.0005623413251903491, 0.00042169650342858224, 0.00031622776601683794,
    0.00023713737056616554, 0.00017782794100389227, 0.0001333521432163324};
__device__ __forceinline__ void sincos_d(double x, float& c, float& s) {
    const double kq = __builtin_rint(x * 0.6366197723675814);
    const double r = (x - kq * 1.5707963267341256) - kq * 6.077094383272197e-11, r2 = r * r;
    const double sr = r + r * r2 * (-1.0 / 6 + r2 * (1.0 / 120 + r2 * (-1.0 / 5040 + r2 * (1.0 / 362880 + r2 * (-1.0 / 39916800 + r2 * (1.0 / 6227020800.0))))));
    const double cr = 1.0 + r2 * (-0.5 + r2 * (1.0 / 24 + r2 * (-1.0 / 720 + r2 * (1.0 / 40320 + r2 * (-1.0 / 3628800 + r2 * (1.0 / 479001600.0))))));
    const int q = (int)kq & 3;
    const double cc = (q == 0) ? cr : (q == 1) ? -sr : (q == 2) ? -cr : sr;
    const double ss = (q == 0) ? sr : (q == 1) ? cr : (q == 2) ? -sr : -cr;
    c = (float)cc; s = (float)ss;
}

struct Frame {
    LAS unsigned char* lds; int tid, lane, wave, vcu, G;
    const float *x, *mem, *g_mix, *g_mem, *w_in, *b_in, *w_up, *b_gate, *g_gnorm, *sinks, *w_mem_kv, *w_br_gla, *w_br_swa, *w_br_mem, *w_out, *g_final;
    float* out; gu32* ctl;
    bf16 *WT, *WBR, *WOUT, *XB, *Z, *GQ, *GK, *GV, *SQ, *SK, *SV, *XQ, *GATES, *MERGED, *MKV;
    float *RSTD, *BIAS, *COS, *SIN, *GLR, *ROWSS;
};

__device__ __forceinline__ int srccol(int t) { return t < 12 ? t * 256 : t < 30 ? 3088 + (t - 12) * 256 : t == 30 ? 3072 : 7696 + (t - 31) * 256; }
__device__ __forceinline__ void tr_item(const float* W, int ldw, int k0, int scol0, int nvalid, const float* ks, int ksmask, bf16* dst, int ldd, int drow0, int dk0, LAS float* scr, int lane) {
#pragma unroll 8
    for (int i = 0; i < 32; ++i) { const int kk = 2 * i + (lane >> 5), n = lane & 31; float v = 0.f;
        if (n < nvalid) { v = W[(size_t)(k0 + kk) * ldw + scol0 + n]; if (ks) v *= ks[(k0 + kk) & ksmask]; }
        scr[kk * 33 + n] = v; }
    LDS_WAIT(); asm volatile("" ::: "memory");
    const int c = lane & 7;
#pragma unroll
    for (int j = 0; j < 4; ++j) { const int n = (lane >> 3) + 8 * j; const LAS float* s = scr + (8 * c) * 33 + n;
        v4u o; o.x = pk2(s[0 * 33], s[1 * 33]); o.y = pk2(s[2 * 33], s[3 * 33]); o.z = pk2(s[4 * 33], s[5 * 33]); o.w = pk2(s[6 * 33], s[7 * 33]);
        *(GAS v4u*)(dst + (size_t)(drow0 + n) * ldd + dk0 + k0 + 8 * c) = o; }
    LDS_WAIT(); asm volatile("" ::: "memory");
}
__device__ __forceinline__ void p0_prologue(Frame& F) {
    LAS float* scr = (LAS float*)(F.lds + F.wave * 16384);
    const int gw = F.vcu * NWAVES + F.wave, NGW = F.G * NWAVES;
    constexpr int NB_IN = (NT1 + NTG) * 8, NB_KV = 64, NB_BR = 96, NB_OUT = 32, NB = NB_IN + NB_KV + NB_BR + NB_OUT;
    for (int it = gw; it < NB * 16; it += NGW) {
        const int kb = it / NB, nb = it % NB, k0 = kb * 64;
        if (nb < NB_IN) { const int tile = nb >> 3, j = nb & 7; const int nvalid = (tile == 30) ? (j == 0 ? 16 : 0) : 32;
            tr_item(F.w_in, INC, k0, srccol(tile) + j * 32, nvalid, F.g_mix, 1023, F.WT, 1024, nb * 32, 0, scr, F.lane); }
        else if (nb < NB_IN + NB_KV) { const int n0 = (nb - NB_IN) * 32; tr_item(F.w_mem_kv, 2048, k0, n0, 32, F.g_mem, 1023, F.WT, 1024, (NT1 + NTG) * 256 + n0, 0, scr, F.lane); }
        else if (nb < NB_IN + NB_KV + NB_BR) { const int r = nb - NB_IN - NB_KV, s = r >> 5, n0 = (r & 31) * 32;
            if (s == 0) tr_item(F.w_br_gla, 1024, k0, n0, 32, F.g_gnorm, 255, F.WBR, 3072, n0, 0, scr, F.lane);
            else if (s == 1) tr_item(F.w_br_swa, 1024, k0, n0, 32, nullptr, 255, F.WBR, 3072, n0, 1024, scr, F.lane);
            else tr_item(F.w_br_mem, 1024, k0, n0, 32, nullptr, 255, F.WBR, 3072, n0, 2048, scr, F.lane); }
        else { const int n0 = (nb - NB_IN - NB_KV - NB_BR) * 32; tr_item(F.w_out, 1024, k0, n0, 32, nullptr, 0, F.WOUT, 1024, n0, 0, scr, F.lane); }
    }
    for (int m = gw; m < T + TM; m += NGW) {
        const float* src = m < T ? F.x + (size_t)m * DM : F.mem + (size_t)(m - T) * DM;
        const GAS f32x4* xr = (const GAS f32x4*)src + F.lane;
        f32x4 v[4]; float s = 0.f;
#pragma unroll
        for (int j = 0; j < 4; ++j) { v[j] = xr[64 * j]; s += (v[j].x * v[j].x + v[j].y * v[j].y) + (v[j].z * v[j].z + v[j].w * v[j].w); }
        const float rstd = 1.f / sqrtf(wave_sum(s) * (1.f / DM) + EPS);
        if (F.lane == 0) F.RSTD[m] = rstd;
        GAS unsigned long long* o8 = (GAS unsigned long long*)(F.XB + (size_t)m * DM) + F.lane;
#pragma unroll
        for (int j = 0; j < 4; ++j) o8[64 * j] = (unsigned long long)pk2(v[j].x, v[j].y) | ((unsigned long long)pk2(v[j].z, v[j].w) << 32);
    }
    const int gt = F.vcu * (NWAVES * 64) + F.tid, NGT = F.G * NWAVES * 64;
    for (int i = gt; i < WT_ROWS; i += NGT) { float b = 0.f;
        if (i < (NT1 + NTG) * 256) { const int tile = i >> 8, j = i & 255; if (tile != 30 || j < 16) b = F.b_in[srccol(tile) + j]; }
        F.BIAS[i] = b; }
    for (int i = gt; i < SEQ * 32; i += NGT) { float c, s; sincos_d((double)(i >> 5) * INVF[i & 31], c, s); F.COS[i] = c; F.SIN[i] = s; }
}

__device__ __forceinline__ void gla_naive_unit(Frame& F, int b, int h) {
    LAS float* sq = (LAS float*)F.lds; LAS float* sk = sq + 8192; LAS float* sa = sk + 8192;
    LAS bf16* sv = (LAS bf16*)(sa + 8192);
    LAS float* sg = (LAS float*)(F.lds + 131072); LAS float* pos = sg + 1024; LAS float* red = pos + 512;
    const int tid = F.tid, dv = tid & 255, dh = tid >> 8;
    float S[64];
#pragma unroll
    for (int i = 0; i < 64; ++i) S[i] = 0.f;
    for (int c = 0; c < SEQ / 64; ++c) {
        const size_t row0 = (size_t)b * SEQ + c * 64;
        for (int i = tid; i < 1024; i += 512) sg[i] = F.GLR[row0 * 16 + i];
        for (int i = tid; i < 64 * 32; i += 512) { const int tok = i >> 5, c8 = i & 31;
            *(LAS v4u*)(sv + tok * 256 + c8 * 8) = *(const GAS v4u*)(F.GV + (row0 + tok) * 1024 + h * 256 + c8 * 8); }
        __syncthreads();
        for (int i = tid; i < 8192; i += 512) { const int tok = i >> 7, d = i & 127;
            float z = F.b_gate[h * 128 + d];
#pragma unroll
            for (int r = 0; r < 16; ++r) z += sg[tok * 16 + r] * F.w_up[r * 512 + h * 128 + d];
            const float ls = fminf(z, 0.f) - log1pf(expf(-fabsf(z)));
            sa[i] = expf(ls * 0.0625f);
            sq[i] = bf2f(F.GQ[(row0 + tok) * 512 + h * 128 + d]) * 0.08838834764831845f;
            sk[i] = bf2f(F.GK[(row0 + tok) * 512 + h * 128 + d]); }
        __syncthreads();
        for (int tok = 0; tok < 64; ++tok) {
            const float vv = bf2f(sv[tok * 256 + dv]); float po = 0.f;
            const LAS float* pa = sa + tok * 128 + dh * 64; const LAS float* pk = sk + tok * 128 + dh * 64; const LAS float* pq = sq + tok * 128 + dh * 64;
#pragma unroll
            for (int i = 0; i < 64; ++i) { S[i] = pa[i] * S[i] + pk[i] * vv; po += pq[i] * S[i]; }
            pos[dh * 256 + dv] = po;
            __syncthreads();
            float o = 0.f;
            if (tid < 256) { o = pos[dv] + pos[256 + dv]; const float ss = wave_sum(o * o); if (F.lane == 0) red[F.wave] = ss; }
            __syncthreads();
            if (tid < 256) { const float tot = (red[0] + red[1]) + (red[2] + red[3]); const float rstd = 1.f / sqrtf(tot * (1.f / 256.f) + EPS);
                bf16* zp = F.Z + (row0 + tok) * 3072 + h * 256 + dv; *zp = (bf16)f2bf(o * rstd * bf2f(*zp)); }
        }
        __syncthreads();
    }
}
__device__ __forceinline__ void swa_naive_unit(Frame& F, int b, int nblk, int g) {
    LAS float* Ks = (LAS float*)F.lds; LAS float* Vs = Ks + 256 * 65; LAS float* qs = Vs + 256 * 65; LAS float* ps = qs + 512;
    const int tid = F.tid, lane = F.lane, w = F.wave;
    for (int i = tid; i < 256 * 32; i += 512) { const int j = i >> 5, ii = i & 31, kp = (nblk - 1) * 128 + j; float a = 0.f, bb = 0.f;
        if (kp >= 0) { const size_t row = (size_t)b * SEQ + kp; const float x1 = bf2f(F.SK[row * 256 + g * 64 + ii]), x2 = bf2f(F.SK[row * 256 + g * 64 + ii + 32]);
            const float c = F.COS[kp * 32 + ii], s = F.SIN[kp * 32 + ii]; a = x1 * c - x2 * s; bb = x2 * c + x1 * s; }
        Ks[j * 65 + ii] = a; Ks[j * 65 + ii + 32] = bb; }
    for (int i = tid; i < 256 * 64; i += 512) { const int j = i >> 6, d = i & 63, kp = (nblk - 1) * 128 + j;
        Vs[j * 65 + d] = kp >= 0 ? bf2f(F.SV[((size_t)b * SEQ + kp) * 256 + g * 64 + d]) : 0.f; }
    __syncthreads();
    const int hq = g * 4 + (w >> 1), tbase = (w & 1) * 64; const float sink = F.sinks[hq];
    for (int r = 0; r < 64; ++r) {
        const int ti = tbase + r, p = nblk * 128 + ti; const size_t row = (size_t)b * SEQ + p;
        const float xv = bf2f(F.SQ[row * 1024 + hq * 64 + lane]), pr = __shfl_xor(xv, 32);
        const float c = F.COS[p * 32 + (lane & 31)], s = F.SIN[p * 32 + (lane & 31)];
        qs[w * 64 + lane] = lane < 32 ? xv * c - pr * s : xv * c + pr * s;
        asm volatile("s_waitcnt lgkmcnt(0)" ::: "memory");
        float sc[4]; bool valid[4]; float mx = sink;
#pragma unroll
        for (int jj = 0; jj < 4; ++jj) { const int j = lane + 64 * jj, kp = (nblk - 1) * 128 + j; valid[jj] = (kp <= p) && (kp > p - 128) && (kp >= 0);
            float acc = 0.f;
            for (int d = 0; d < 64; ++d) acc += qs[w * 64 + d] * Ks[j * 65 + d];
            sc[jj] = acc * 0.125f; if (valid[jj]) mx = fmaxf(mx, sc[jj]); }
        mx = wave_max(mx);
        float sum = 0.f, pj[4];
#pragma unroll
        for (int jj = 0; jj < 4; ++jj) { pj[jj] = valid[jj] ? __expf(sc[jj] - mx) : 0.f; sum += pj[jj]; }
        sum = wave_sum(sum) + __expf(sink - mx);
        const float inv = 1.f / sum;
#pragma unroll
        for (int jj = 0; jj < 4; ++jj) ps[w * 256 + lane + 64 * jj] = pj[jj] * inv;
        asm volatile("s_waitcnt lgkmcnt(0)" ::: "memory");
        float o = 0.f;
        for (int j = 0; j < 256; ++j) o += ps[w * 256 + j] * Vs[j * 65 + lane];
        bf16* zp = F.Z + row * 3072 + 1024 + hq * 64 + lane; *zp = (bf16)f2bf(o * bf2f(*zp));
        asm volatile("" ::: "memory");
    }
    __syncthreads();
}
__device__ __forceinline__ void xat_naive_unit(Frame& F, int b, int h, int qb) {
    LAS bf16* Ks = (LAS bf16*)F.lds;
    LAS float* scr = (LAS float*)(F.lds + 132096) + F.wave * 512;
    const int tid = F.tid, lane = F.lane, w = F.wave;
    for (int i = tid; i < 256 * 32; i += 512) { const int m = i >> 5, c8 = i & 31;
        const v4u v = *(const GAS v4u*)(F.MKV + ((size_t)b * MEM + m) * 2048 + h * 256 + c8 * 8);
        LAS unsigned* d = (LAS unsigned*)(Ks + m * 258 + c8 * 8); d[0] = v.x; d[1] = v.y; d[2] = v.z; d[3] = v.w; }
    __syncthreads();
    for (int it = 0; it < 16; ++it) {
        const size_t row = (size_t)b * SEQ + qb * 256 + w * 32 + it * 2;
#pragma unroll
        for (int rr = 0; rr < 2; ++rr) { const unsigned long long q4 = *(const GAS unsigned long long*)(F.XQ + (row + rr) * 1024 + h * 256 + lane * 4);
            const unsigned lo = (unsigned)q4, hi = (unsigned)(q4 >> 32);
            scr[rr * 256 + lane * 4 + 0] = pg8::bflo(lo) * 0.0625f; scr[rr * 256 + lane * 4 + 1] = pg8::bfhi(lo) * 0.0625f;
            scr[rr * 256 + lane * 4 + 2] = pg8::bflo(hi) * 0.0625f; scr[rr * 256 + lane * 4 + 3] = pg8::bfhi(hi) * 0.0625f; }
        asm volatile("s_waitcnt lgkmcnt(0)" ::: "memory");
        float acc[2][4];
#pragma unroll
        for (int rr = 0; rr < 2; ++rr)
#pragma unroll
            for (int jj = 0; jj < 4; ++jj) acc[rr][jj] = 0.f;
        for (int d2 = 0; d2 < 128; ++d2) {
            const float q00 = scr[2 * d2], q01 = scr[2 * d2 + 1], q10 = scr[256 + 2 * d2], q11 = scr[256 + 2 * d2 + 1];
#pragma unroll
            for (int jj = 0; jj < 4; ++jj) { const unsigned kw = *(const LAS unsigned*)(Ks + (lane + 64 * jj) * 258 + 2 * d2);
                const float k0 = pg8::bflo(kw), k1 = pg8::bfhi(kw);
                acc[0][jj] += q00 * k0 + q01 * k1; acc[1][jj] += q10 * k0 + q11 * k1; }
        }
        asm volatile("" ::: "memory");
#pragma unroll
        for (int rr = 0; rr < 2; ++rr) {
            float mx = fmaxf(fmaxf(acc[rr][0], acc[rr][1]), fmaxf(acc[rr][2], acc[rr][3])); mx = wave_max(mx);
            float pj[4], sum = 0.f;
#pragma unroll
            for (int jj = 0; jj < 4; ++jj) { pj[jj] = __expf(acc[rr][jj] - mx); sum += pj[jj]; }
            const float inv = 1.f / wave_sum(sum);
#pragma unroll
            for (int jj = 0; jj < 4; ++jj) scr[rr * 256 + lane + 64 * jj] = pj[jj] * inv;
        }
        asm volatile("s_waitcnt lgkmcnt(0)" ::: "memory");
        float o[2][4];
#pragma unroll
        for (int rr = 0; rr < 2; ++rr)
#pragma unroll
            for (int e = 0; e < 4; ++e) o[rr][e] = 0.f;
        const bf16* vb = F.MKV + (size_t)b * MEM * 2048 + 1024 + h * 256 + lane * 4;
        for (int m = 0; m < 256; ++m) { const unsigned long long v4 = *(const GAS unsigned long long*)(vb + (size_t)m * 2048);
            const unsigned lo = (unsigned)v4, hi = (unsigned)(v4 >> 32); const float v0 = pg8::bflo(lo), v1 = pg8::bfhi(lo), v2 = pg8::bflo(hi), v3 = pg8::bfhi(hi);
            const float p0 = scr[m], p1 = scr[256 + m];
            o[0][0] += p0 * v0; o[0][1] += p0 * v1; o[0][2] += p0 * v2; o[0][3] += p0 * v3;
            o[1][0] += p1 * v0; o[1][1] += p1 * v1; o[1][2] += p1 * v2; o[1][3] += p1 * v3; }
#pragma unroll
        for (int rr = 0; rr < 2; ++rr) { GAS unsigned long long* zp = (GAS unsigned long long*)(F.Z + (row + rr) * 3072 + 2048 + h * 256 + lane * 4);
            const unsigned long long z4 = *zp; const unsigned lo = (unsigned)z4, hi = (unsigned)(z4 >> 32);
            *zp = (unsigned long long)pk2(o[rr][0] * pg8::bflo(lo), o[rr][1] * pg8::bfhi(lo)) | ((unsigned long long)pk2(o[rr][2] * pg8::bflo(hi), o[rr][3] * pg8::bfhi(hi)) << 32); }
        asm volatile("s_waitcnt lgkmcnt(0)" ::: "memory");
    }
    __syncthreads();
}

struct Args { const float* in[16]; float* out; unsigned char* ws; int ph_lo, ph_hi; };
__global__ void __launch_bounds__(NWAVES * 64, 2) fwd(Args args) {
    extern __shared__ __attribute__((aligned(16))) unsigned char lds_raw[];
    Frame F;
    F.lds = (LAS unsigned char*)lds_raw;
    F.tid = threadIdx.x; F.lane = F.tid & 63; F.wave = __builtin_amdgcn_readfirstlane(F.tid >> 6);
    F.G = gridDim.x; { const int bx = blockIdx.x; F.vcu = (F.G % 8 == 0) ? (bx % 8) * (F.G / 8) + bx / 8 : bx; }
    unsigned char* ws = args.ws; unsigned char* dob = (unsigned char*)args.out;
    F.x = args.in[0]; F.mem = args.in[1]; F.g_mix = args.in[2]; F.g_mem = args.in[3]; F.w_in = args.in[4]; F.b_in = args.in[5]; F.w_up = args.in[6]; F.b_gate = args.in[7];
    F.g_gnorm = args.in[8]; F.sinks = args.in[9]; F.w_mem_kv = args.in[10]; F.w_br_gla = args.in[11]; F.w_br_swa = args.in[12]; F.w_br_mem = args.in[13]; F.w_out = args.in[14]; F.g_final = args.in[15];
    F.out = args.out; F.ctl = (gu32*)(ws + WS_CTL);
    F.WT = (bf16*)(ws + WS_WT); F.WBR = (bf16*)(ws + WS_WBR); F.WOUT = (bf16*)(ws + WS_WOUT); F.RSTD = (float*)(ws + WS_RSTD); F.BIAS = (float*)(ws + WS_BIAS);
    F.COS = (float*)(ws + WS_COS); F.SIN = (float*)(ws + WS_SIN); F.GLR = (float*)(ws + WS_GLR); F.ROWSS = (float*)(ws + WS_CTL + CTL_ROWSS);
    F.Z = (bf16*)(ws + WS_Z); F.GQ = (bf16*)(ws + WS_GQ); F.GK = (bf16*)(ws + WS_GK); F.GV = (bf16*)(ws + WS_GV); F.SQ = (bf16*)(ws + WS_SQ); F.XQ = (bf16*)(ws + WS_XQ);
    F.GATES = (bf16*)(ws + WS_GATES); F.MERGED = (bf16*)(ws + WS_MERGED);
    F.XB = (bf16*)(dob + DO_XB); F.SK = (bf16*)(dob + DO_SK); F.SV = (bf16*)(dob + DO_SV); F.MKV = (bf16*)(dob + DO_MKV);
    volatile LAS unsigned* MISC = (volatile LAS unsigned*)(F.lds + MISC_OFF);
    for (int u = F.tid; u < (LDS_BYTES - MISC_OFF) / 4; u += NWAVES * 64) MISC[u] = 0u;
    __syncthreads();
    XcdBarrier bar; bar.bar = (unsigned*)(F.ctl + CW_BAR); bar.x = 0; bar.st = nullptr;
    if (N_LAUNCHES == 1) bar = xcd_barrier_post((unsigned*)(F.ctl + CW_BAR), MISC + 8);
    const int lo = args.ph_lo, hi = args.ph_hi;
#define IN(k) (lo <= (k) && (k) < hi)
#define SEAM(k) do { if (IN(k) && IN((k) + 1)) xcd_barrier(bar); } while (0)

    if (IN(0)) { p0_prologue(F); SEAM(0); }

    if (IN(1)) {
        pg8::Gemm g{F.XB, F.WT, 1024, 1024, 1024}; pg8::RectOrder S; S.init(T / 256, NT1, 0, TM / 256, NTKV, T / 256, NT1 + NTG, F.G, (int)blockIdx.x);
        pg8::EpiProj E{F.RSTD, F.BIAS, F.GLR, F.GQ, F.GK, F.GV, F.Z, F.SQ, F.SK, F.SV, F.XQ, F.GATES, F.MKV};
        pg8::gemm_phase<pg8::EpiProj, pg8::RectOrder, true, true>(F.lds, g, S, E);
        SEAM(1);
    }

    if (IN(2)) {
        for (int u = blockIdx.x; u < 1600; u += F.G) {
            if (u < 64) gla_naive_unit(F, u >> 2, u & 3);
            else if (u < 576) { const int i = u - 64; xat_naive_unit(F, i >> 5, (i >> 3) & 3, i & 7); }
            else { const int i = u - 576; swa_naive_unit(F, i >> 6, (i >> 2) & 15, i & 3); }
        }
        SEAM(2);
    }

    if (IN(3)) {
        pg8::Gemm g{F.XB, F.WT, 1024, 1024, 1024}; pg8::RectOrder S; S.init(T / 256, NTG, NT1, 0, 0, 0, 0, F.G, (int)blockIdx.x);
        pg8::EpiProj E{F.RSTD, F.BIAS, F.GLR, F.GQ, F.GK, F.GV, F.Z, F.SQ, F.SK, F.SV, F.XQ, F.GATES, F.MKV};
        pg8::gemm_phase<pg8::EpiProj, pg8::RectOrder, true, true>(F.lds, g, S, E);
        SEAM(3);
    }

#pragma unroll 1
    for (int j = 0; j < 3; ++j) if (IN(4 + j)) {
        pg8::Gemm g{F.Z + j * 1024, F.WBR + j * 1024, 3072, 3072, 1024}; pg8::RectOrder S; S.init(T / 256, 4, 0, 0, 0, 0, 0, F.G, (int)blockIdx.x);
        pg8::EpiBranch E{F.GATES, F.MERGED, j};
        pg8::gemm_phase<pg8::EpiBranch, pg8::RectOrder, true, true>(F.lds, g, S, E);
        SEAM(4 + j);
    }

    if (IN(7)) {
        pg8::Gemm g{F.MERGED, F.WOUT, 1024, 1024, 1024}; pg8::RectOrder S; S.init(T / 256, 4, 0, 0, 0, 0, 0, F.G, (int)blockIdx.x);
        pg8::EpiOut E{F.x, F.out, F.ROWSS};
        pg8::gemm_phase<pg8::EpiOut, pg8::RectOrder, true, true>(F.lds, g, S, E);
        SEAM(7);
    }

    if (IN(8)) {
        const int gw = F.vcu * NWAVES + F.wave, NGW = F.G * NWAVES;
        for (int m = gw; m < T; m += NGW) {
            const float rstd = 1.f / sqrtf(__hip_atomic_load(F.ROWSS + m, __ATOMIC_RELAXED, __HIP_MEMORY_SCOPE_AGENT) * (1.f / DM) + EPS);
            GAS f32x4* o = (GAS f32x4*)(F.out + (size_t)m * DM) + F.lane; const GAS f32x4* gf = (const GAS f32x4*)F.g_final + F.lane;
#pragma unroll
            for (int j = 0; j < 4; ++j) o[64 * j] = o[64 * j] * rstd * gf[64 * j];
        }
    }
#undef IN
#undef SEAM
}

extern "C" void kernel_launch(void* const* d_in, const int* in_sizes, int n_in, void* d_out, int out_size, void* d_ws, size_t ws_size, hipStream_t stream) {
    static int grid = 0;
    if (grid == 0) {
        if (n_in != 16 || in_sizes[0] != T * DM || out_size != T * DM || ws_size < WS_END) {
            fprintf(stderr, "kernel_launch: unexpected shapes (n_in %d, in0 %d, out %d, ws %zu); nothing launched\n", n_in, n_in > 0 ? in_sizes[0] : -1, out_size, ws_size); grid = -1; return; }
        int dev = 0, cus = 0, per_cu = 0;
        if (hipGetDevice(&dev) != hipSuccess || hipDeviceGetAttribute(&cus, hipDeviceAttributeMultiprocessorCount, dev) != hipSuccess) { grid = -1; return; }
        if (hipFuncSetAttribute((const void*)fwd, hipFuncAttributeMaxDynamicSharedMemorySize, LDS_BYTES) != hipSuccess) { fprintf(stderr, "kernel_launch: hipFuncSetAttribute failed\n"); grid = -1; return; }
        if (hipOccupancyMaxActiveBlocksPerMultiprocessor(&per_cu, (const void*)fwd, NWAVES * 64, LDS_BYTES) != hipSuccess || per_cu < 1) {
            fprintf(stderr, "kernel_launch: occupancy query reports %d workgroups per CU; nothing launched\n", per_cu); (void)hipGetLastError(); grid = -1; return; }
        grid = cus;
    }
    if (grid < 0) return;
    if (hipMemsetAsync((char*)d_ws + WS_CTL, 0, CTL_ZERO_BYTES, stream) != hipSuccess) return;
    Args a{};
    for (int i = 0; i < 16; ++i) a.in[i] = (const float*)d_in[i];
    a.out = (float*)d_out; a.ws = (unsigned char*)d_ws;
    if (N_LAUNCHES == 1) { a.ph_lo = 0; a.ph_hi = N_PHASES; hipLaunchKernelGGL(fwd, dim3(grid), dim3(NWAVES * 64), LDS_BYTES, stream, a); }
    else for (int li = 0; li < N_PHASES; ++li) { a.ph_lo = li; a.ph_hi = li + 1; hipLaunchKernelGGL(fwd, dim3(grid), dim3(NWAVES * 64), LDS_BYTES, stream, a); }
}
```

```cpp
#include <hip/hip_runtime.h>
#include <cstdio>
#include <cstdint>
namespace pg8 {
#define PG8_LAS __attribute__((address_space(3)))
typedef unsigned short bf16_t;
typedef short bf16x8 __attribute__((ext_vector_type(8)));
typedef float f32x4 __attribute__((ext_vector_type(4)));
typedef unsigned u32x4 __attribute__((ext_vector_type(4)));
constexpr int BM = 256, BK = 64, HALF = 128, HTB = HALF * BK * 2  , STAGE_BYTES = 8 * HTB, NXCD = 8, WGM = 8;

__host__ __device__ __forceinline__ int lds_byte(int r, int c) { const int st = (r >> 4) * 2 + (c >> 5), rr = r & 15, cc = c & 31, ob = rr * 64 + cc * 2; return st * 1024 + (ob ^ (((ob >> 9) & 1) << 5)); }
__host__ __device__ __forceinline__ void stage_rc(int b, int& R, int& C) { const int st = b / 1024, sb = b % 1024, swz = sb ^ (((sb >> 9) & 1) << 5); R = (st >> 1) * 16 + swz / 64; C = (st & 1) * 32 + (swz % 64) / 2; }
__host__ __device__ __forceinline__ int perm32(int rho) { const int n = rho >> 4, i = rho & 15; return 8 * (i >> 2) + 4 * n + (i & 3); }

struct Unit { int pm, pn; };
struct Gemm { const bf16_t* A; const bf16_t* Bt; int lda, ldb, K; };


struct RectOrder {
    int nM, nN, pn0, nwg1, nM2, pm2, pn2, nwg, G, c;
    __device__ void init(int nM_, int nN_, int pn0_, int nM2_, int nN2_, int pm2_, int pn2_, int G_, int c_) {
        nM = nM_; nN = nN_; pn0 = pn0_; nwg1 = nM_ * nN_; nM2 = nM2_ > 0 ? nM2_ : 1; pm2 = pm2_; pn2 = pn2_; nwg = nwg1 + nM2_ * nN2_; G = G_; c = c_; }
    __device__ bool next(int i, Unit& u) const {
        const long L = (long)i * G + c; if (L >= nwg) return false;
        if (L < nwg1) {
            int wgid = (int)L; { const int q = nwg1 / NXCD, r = nwg1 % NXCD, xcd = wgid % NXCD, off = wgid / NXCD; wgid = (xcd < r ? xcd * (q + 1) : r * (q + 1) + (xcd - r) * q) + off; }
            const int nig = WGM * nN, gid = wgid / nig, fm = gid * WGM, gsz = (nM - fm) < WGM ? (nM - fm) : WGM;
            u.pm = fm + ((wgid % nig) % gsz); u.pn = pn0 + (wgid % nig) / gsz;
        } else { const int r = (int)L - nwg1; u.pm = pm2 + r % nM2; u.pn = pn2 + r / nM2; }
        return true;
    }
    __device__ __forceinline__ void a_ready(const Unit&) const {}
    __device__ __forceinline__ void done(const Unit&) const {}
};

__device__ __forceinline__ unsigned cvt_pk_bf16(float lo, float hi) { unsigned r; asm volatile("v_cvt_pk_bf16_f32 %0, %1, %2" : "=v"(r) : "v"(lo), "v"(hi)); return r; }
__device__ __forceinline__ float bflo(unsigned w) { return __builtin_bit_cast(float, w << 16); }
__device__ __forceinline__ float bfhi(unsigned w) { return __builtin_bit_cast(float, w & 0xffff0000u); }
__device__ __forceinline__ float sigm(float v) { return __builtin_amdgcn_rcpf(1.f + __expf(-v)); }

struct EpiProj {
    static constexpr bool PERM = true, AFTER_DRAIN = false;
    const float* rstd; const float* bias; float* glr;
    bf16_t *GQ, *GK, *GV, *Z, *SQ, *SK, *SV, *XQ, *GATES, *MKV;
    __device__ __forceinline__ void operator()(const f32x4 (&acc)[2][2][4][2], const Unit& u, int wr, int wc, int fr, int fq) const {
        const int pn = u.pn; bf16_t* base; int ld, ct, act = 0, rowoff = 0;
        if (pn < 2) { base = GQ; ld = 512; ct = pn; }
        else if (pn < 4) { base = GK; ld = 512; ct = pn - 2; }
        else if (pn < 8) { base = GV; ld = 1024; ct = pn - 4; }
        else if (pn < 12) { base = Z; ld = 3072; ct = pn - 8; act = 1; }
        else if (pn < 16) { base = SQ; ld = 1024; ct = pn - 12; }
        else if (pn == 16) { base = SK; ld = 256; ct = 0; }
        else if (pn == 17) { base = SV; ld = 256; ct = 0; }
        else if (pn < 22) { base = Z + 1024; ld = 3072; ct = pn - 18; act = 1; }
        else if (pn < 26) { base = XQ; ld = 1024; ct = pn - 22; }
        else if (pn < 30) { base = Z + 2048; ld = 3072; ct = pn - 26; act = 1; }
        else if (pn == 30) { base = nullptr; ld = 16; ct = 0; act = 3; }
        else if (pn < 43) { base = GATES; ld = 3072; ct = pn - 31; act = 2; }
        else { base = MKV; ld = 2048; ct = pn - 43; rowoff = 32768; }
        const int row0 = u.pm * BM + wr * 64 + fr;
        const int colL = ct * BM + wc * 32 + 8 * fq, bcol0 = pn * BM + wc * 32 + 8 * fq;
        float rs[2][4];
#pragma unroll
        for (int ai = 0; ai < 2; ++ai)
#pragma unroll
            for (int m = 0; m < 4; ++m) rs[ai][m] = rstd[row0 + ai * HALF + m * 16];
        if (act == 3) {
            if (wc == 0 && fq < 2) {
                const f32x4 b0 = *(const f32x4*)(bias + bcol0), b1 = *(const f32x4*)(bias + bcol0 + 4);
#pragma unroll
                for (int ai = 0; ai < 2; ++ai)
#pragma unroll
                    for (int m = 0; m < 4; ++m) { float* rp = glr + (size_t)(row0 + ai * HALF + m * 16) * 16 + 8 * fq;
                        *(f32x4*)rp = acc[ai][0][m][0] * rs[ai][m] + b0; *(f32x4*)(rp + 4) = acc[ai][0][m][1] * rs[ai][m] + b1; }
            }
            return;
        }
        f32x4 bv[2][2];
#pragma unroll
        for (int bj = 0; bj < 2; ++bj)
#pragma unroll
            for (int n = 0; n < 2; ++n) bv[bj][n] = *(const f32x4*)(bias + bcol0 + bj * HALF + 4 * n);
#pragma unroll
        for (int ai = 0; ai < 2; ++ai)
#pragma unroll
            for (int m = 0; m < 4; ++m) { bf16_t* rowp = base + (size_t)(row0 - rowoff + ai * HALF + m * 16) * ld + colL;
#pragma unroll
                for (int bj = 0; bj < 2; ++bj) { f32x4 v0 = acc[ai][bj][m][0] * rs[ai][m] + bv[bj][0], v1 = acc[ai][bj][m][1] * rs[ai][m] + bv[bj][1];
                    if (act == 1) {
#pragma unroll
                        for (int e = 0; e < 4; ++e) { v0[e] = v0[e] * sigm(v0[e]); v1[e] = v1[e] * sigm(v1[e]); } }
                    else if (act == 2) {
#pragma unroll
                        for (int e = 0; e < 4; ++e) { v0[e] = sigm(v0[e]); v1[e] = sigm(v1[e]); } }
                    u32x4 w; w.x = cvt_pk_bf16(v0[0], v0[1]); w.y = cvt_pk_bf16(v0[2], v0[3]); w.z = cvt_pk_bf16(v1[0], v1[1]); w.w = cvt_pk_bf16(v1[2], v1[3]);
                    *(u32x4*)(rowp + bj * HALF) = w; } }
    }
};

struct EpiBranch {
    static constexpr bool PERM = true, AFTER_DRAIN = false;
    const bf16_t* GATES; bf16_t* MERGED; int j;
    __device__ __forceinline__ void operator()(const f32x4 (&acc)[2][2][4][2], const Unit& u, int wr, int wc, int fr, int fq) const {
        const int row0 = u.pm * BM + wr * 64 + fr, col0 = u.pn * BM + wc * 32 + 8 * fq;
#pragma unroll
        for (int ai = 0; ai < 2; ++ai)
#pragma unroll
            for (int m = 0; m < 4; ++m) { const size_t r = (size_t)(row0 + ai * HALF + m * 16);
#pragma unroll
                for (int bj = 0; bj < 2; ++bj) { const int c = col0 + bj * HALF;
                    const u32x4 g = *(const u32x4*)(GATES + r * 3072 + j * 1024 + c);
                    u32x4 o = (u32x4){0u, 0u, 0u, 0u}; if (j > 0) o = *(const u32x4*)(MERGED + r * 1024 + c);
                    const f32x4 a0 = acc[ai][bj][m][0], a1 = acc[ai][bj][m][1];
                    u32x4 w;
                    w.x = cvt_pk_bf16(bflo(o.x) + bflo(g.x) * a0[0], bfhi(o.x) + bfhi(g.x) * a0[1]);
                    w.y = cvt_pk_bf16(bflo(o.y) + bflo(g.y) * a0[2], bfhi(o.y) + bfhi(g.y) * a0[3]);
                    w.z = cvt_pk_bf16(bflo(o.z) + bflo(g.z) * a1[0], bfhi(o.z) + bfhi(g.z) * a1[1]);
                    w.w = cvt_pk_bf16(bflo(o.w) + bflo(g.w) * a1[2], bfhi(o.w) + bfhi(g.w) * a1[3]);
                    *(u32x4*)(MERGED + r * 1024 + c) = w; } }
    }
};

struct EpiOut {
    static constexpr bool PERM = false, AFTER_DRAIN = false;
    const float* x; float* out; float* rowss;
    __device__ __forceinline__ void operator()(const f32x4 (&acc)[2][2][4][2], const Unit& u, int wr, int wc, int fr, int fq) const {
        const int row0 = u.pm * BM + wr * 64 + fr, col0 = u.pn * BM + wc * 32 + 4 * fq;
#pragma unroll
        for (int ai = 0; ai < 2; ++ai)
#pragma unroll
            for (int m = 0; m < 4; ++m) { const size_t r = (size_t)(row0 + ai * HALF + m * 16); float s = 0.f;
#pragma unroll
                for (int bj = 0; bj < 2; ++bj)
#pragma unroll
                    for (int n = 0; n < 2; ++n) { const size_t off = r * 1024 + col0 + bj * HALF + n * 16;
                        const f32x4 y = *(const f32x4*)(x + off) + acc[ai][bj][m][n]; *(f32x4*)(out + off) = y;
                        s += (y[0] * y[0] + y[1] * y[1]) + (y[2] * y[2] + y[3] * y[3]); }
                s += __shfl_xor(s, 16); s += __shfl_xor(s, 32);
                if (fq == 0) atomicAdd(rowss + r, s); }
    }
};

template <class Epi, class Sched, bool ALIGN_EPI = false, bool SP2 = false>
__device__ __forceinline__ void gemm_phase(PG8_LAS unsigned char* lds, const Gemm g, const Sched& S, const Epi& E) {
    const int tid = threadIdx.x, wid = __builtin_amdgcn_readfirstlane(tid >> 6), lane = tid & 63, wr = wid >> 2, wc = wid & 3, fr = lane & 15, fq = lane >> 4;
    const int K = g.K, nt = K / BK;
    unsigned voffA[2], voffB[2];
#pragma unroll
    for (int i = 0; i < 2; ++i) { int R, C; stage_rc(tid * 16 + i * 8192, R, C); const int Rb = Epi::PERM ? ((R & ~31) + perm32(R & 31)) : R;
        voffA[i] = (unsigned)(R * g.lda + C) * 2u; voffB[i] = (unsigned)(Rb * g.ldb + C) * 2u; }
    const size_t kstep = (size_t)(BK * 2);
    const size_t hstepA = (size_t)HALF * g.lda * 2, hstepB = (size_t)HALF * g.ldb * 2;
    const size_t tstepA = 2 * hstepA, tstepB = 2 * hstepB;
    const unsigned ldsw = (unsigned)wid * 1024u;
    const int aoff = lds_byte(wr * 64 + fr, fq * 8), boff = lds_byte(wc * 32 + fr, fq * 8);
#define PG8_SA(b, h) (((b) * 2 + (h)) * HTB)
#define PG8_SB(b, h) ((4 + (b) * 2 + (h)) * HTB)
#define PG8_STAGE(bufoff, gbase, voff) do { _Pragma("unroll") for (int _i = 0; _i < 2; ++_i) \
        __builtin_amdgcn_global_load_lds((const unsigned*)((const char*)(gbase) + (voff)[_i]), (PG8_LAS unsigned*)(lds + (bufoff) + ldsw + _i * 8192), 16, 0, 0); } while (0)
#define PG8_LDA(dst, b, h) do { _Pragma("unroll") for (int m = 0; m < 4; ++m) _Pragma("unroll") for (int k = 0; k < 2; ++k) dst[m][k] = *(const PG8_LAS bf16x8*)(lds + PG8_SA(b, h) + aoff + m * 2048 + k * 1024); } while (0)
#define PG8_LDB(dst, b, h) do { _Pragma("unroll") for (int n = 0; n < 2; ++n) _Pragma("unroll") for (int k = 0; k < 2; ++k) dst[n][k] = *(const PG8_LAS bf16x8*)(lds + PG8_SB(b, h) + boff + n * 2048 + k * 1024); } while (0)
#define PG8_MMA(ai, bj, At, Bt) do { __builtin_amdgcn_s_setprio(1); _Pragma("unroll") for (int m = 0; m < 4; ++m) _Pragma("unroll") for (int n = 0; n < 2; ++n) _Pragma("unroll") for (int k = 0; k < 2; ++k) \
        acc[ai][bj][m][n] = __builtin_amdgcn_mfma_f32_16x16x32_bf16(Bt[n][k], At[m][k], acc[ai][bj][m][n], 0, 0, 0); __builtin_amdgcn_s_setprio(0); } while (0)
#define PG8_WAIT_V(n) asm volatile("s_waitcnt vmcnt(" #n ")" ::: "memory")
#define PG8_WAIT_L(n) asm volatile("s_waitcnt lgkmcnt(" #n ")" ::: "memory")
#define PG8_BAR __builtin_amdgcn_s_barrier()
#define PG8_SCHED __builtin_amdgcn_sched_barrier(0)
    Unit cur, nxt; int ui = 0;
    if (!S.next(0, cur)) return;
    f32x4 acc[2][2][4][2];
#pragma unroll
    for (int a = 0; a < 2; ++a)
#pragma unroll
        for (int b = 0; b < 2; ++b)
#pragma unroll
            for (int m = 0; m < 4; ++m)
#pragma unroll
                for (int n = 0; n < 2; ++n) acc[a][b][m][n] = (f32x4){0.f, 0.f, 0.f, 0.f};
    bf16x8 At[4][2], B0[2][2], B1[2][2];
    const char* cA = (const char*)g.A + (size_t)cur.pm * tstepA; const char* cB = (const char*)g.Bt + (size_t)cur.pn * tstepB;
    S.a_ready(cur);
    if constexpr (SP2) {
        PG8_STAGE(PG8_SB(0, 0), cB, voffB); PG8_STAGE(PG8_SB(0, 1), cB + hstepB, voffB); PG8_STAGE(PG8_SA(0, 0), cA, voffA); PG8_STAGE(PG8_SA(0, 1), cA + hstepA, voffA);
        if (wr == 1) PG8_BAR;
        PG8_WAIT_V(2); PG8_BAR;
        PG8_STAGE(PG8_SB(1, 0), cB + kstep, voffB); PG8_STAGE(PG8_SA(1, 0), cA + kstep, voffA); PG8_STAGE(PG8_SB(1, 1), cB + hstepB + kstep, voffB);
        PG8_WAIT_V(6); PG8_BAR;
    } else {
        PG8_STAGE(PG8_SB(0, 0), cB, voffB); PG8_STAGE(PG8_SA(0, 0), cA, voffA); PG8_STAGE(PG8_SB(0, 1), cB + hstepB, voffB); PG8_STAGE(PG8_SA(0, 1), cA + hstepA, voffA);
        if (wr == 1) PG8_BAR;
        PG8_WAIT_V(4); PG8_BAR;
        PG8_STAGE(PG8_SB(1, 0), cB + kstep, voffB); PG8_STAGE(PG8_SA(1, 0), cA + kstep, voffA); PG8_STAGE(PG8_SB(1, 1), cB + hstepB + kstep, voffB);
        PG8_WAIT_V(6); PG8_BAR;
    }
    for (;;) {
        const bool has_next = S.next(ui + 1, nxt);
        const char* nA = has_next ? (const char*)g.A + (size_t)nxt.pm * tstepA : cA; const char* nB = has_next ? (const char*)g.Bt + (size_t)nxt.pn * tstepB : cB;
        for (int t = 0; t < nt; t += 2) {
            const bool last = (t == nt - 2);
            const char* a1 = cA + (size_t)(t + 1) * kstep;
            const char* a2 = last ? nA : cA + (size_t)(t + 2) * kstep; const char* b2 = last ? nB : cB + (size_t)(t + 2) * kstep;
            const char* a3 = a2 + kstep; const char* b3 = b2 + kstep;
            if (last && has_next) S.a_ready(nxt);
            if constexpr (SP2) {
            PG8_LDB(B0, 0, 0); PG8_LDB(B1, 0, 1); PG8_SCHED; PG8_LDA(At, 0, 0); PG8_STAGE(PG8_SA(1, 1), a1 + hstepA, voffA);
            PG8_WAIT_V(8); PG8_WAIT_L(0); PG8_BAR; PG8_MMA(0, 0, At, B0); PG8_MMA(0, 1, At, B1); PG8_BAR; PG8_SCHED;
            PG8_LDA(At, 0, 1); PG8_STAGE(PG8_SB(0, 0), b2, voffB); PG8_STAGE(PG8_SB(0, 1), b2 + hstepB, voffB); PG8_STAGE(PG8_SA(0, 0), a2, voffA);
            PG8_WAIT_V(8); PG8_WAIT_L(0); PG8_BAR; PG8_MMA(1, 0, At, B0); PG8_MMA(1, 1, At, B1); PG8_BAR; PG8_SCHED;
            PG8_LDB(B0, 1, 0); PG8_LDB(B1, 1, 1); PG8_SCHED; PG8_LDA(At, 1, 0); PG8_STAGE(PG8_SA(0, 1), a2 + hstepA, voffA);
            PG8_WAIT_V(8); PG8_WAIT_L(0); PG8_BAR; PG8_MMA(0, 0, At, B0); PG8_MMA(0, 1, At, B1); PG8_BAR; PG8_SCHED;
            PG8_LDA(At, 1, 1); PG8_STAGE(PG8_SB(1, 0), b3, voffB); PG8_STAGE(PG8_SB(1, 1), b3 + hstepB, voffB); PG8_STAGE(PG8_SA(1, 0), a3, voffA);
            PG8_WAIT_V(8); PG8_WAIT_L(0); PG8_BAR; PG8_MMA(1, 0, At, B0); PG8_MMA(1, 1, At, B1); PG8_BAR; PG8_SCHED;
            } else {
            PG8_LDB(B0, 0, 0); PG8_SCHED; PG8_LDA(At, 0, 0); PG8_STAGE(PG8_SA(1, 1), a1 + hstepA, voffA);
            PG8_WAIT_L(8); PG8_BAR; PG8_WAIT_L(0); PG8_MMA(0, 0, At, B0); PG8_BAR; PG8_SCHED;
            PG8_LDB(B1, 0, 1); PG8_STAGE(PG8_SB(0, 0), b2, voffB);
            PG8_BAR; PG8_WAIT_L(0); PG8_MMA(0, 1, At, B1); PG8_BAR;
            PG8_LDA(At, 0, 1); PG8_STAGE(PG8_SA(0, 0), a2, voffA);
            PG8_BAR; PG8_WAIT_L(0); PG8_MMA(1, 0, At, B0); PG8_BAR; PG8_SCHED;
            PG8_STAGE(PG8_SB(0, 1), b2 + hstepB, voffB);
            PG8_WAIT_V(6); PG8_BAR; PG8_MMA(1, 1, At, B1); PG8_BAR;
            PG8_LDB(B0, 1, 0); PG8_SCHED; PG8_LDA(At, 1, 0); PG8_STAGE(PG8_SA(0, 1), a2 + hstepA, voffA);
            PG8_WAIT_L(8); PG8_BAR; PG8_WAIT_L(0); PG8_MMA(0, 0, At, B0); PG8_BAR; PG8_SCHED;
            PG8_LDB(B1, 1, 1); PG8_STAGE(PG8_SB(1, 0), b3, voffB);
            PG8_BAR; PG8_WAIT_L(0); PG8_MMA(0, 1, At, B1); PG8_BAR;
            PG8_LDA(At, 1, 1); PG8_STAGE(PG8_SA(1, 0), a3, voffA);
            PG8_BAR; PG8_WAIT_L(0); PG8_MMA(1, 0, At, B0); PG8_BAR; PG8_SCHED;
            PG8_STAGE(PG8_SB(1, 1), b3 + hstepB, voffB);
            PG8_WAIT_V(6); PG8_BAR; PG8_MMA(1, 1, At, B1); PG8_BAR;
            }
        }
        if constexpr (ALIGN_EPI) { if (wr == 0) PG8_BAR; }
        if constexpr (!Epi::AFTER_DRAIN) { E(acc, cur, wr, wc, fr, fq); S.done(cur); }
        if (!has_next) break;
#pragma unroll
        for (int a = 0; a < 2; ++a)
#pragma unroll
            for (int b = 0; b < 2; ++b)
#pragma unroll
                for (int m = 0; m < 4; ++m)
#pragma unroll
                    for (int n = 0; n < 2; ++n) acc[a][b][m][n] = (f32x4){0.f, 0.f, 0.f, 0.f};
        cur = nxt; cA = nA; cB = nB; ++ui;
        if constexpr (ALIGN_EPI) { if (wr == 1) PG8_BAR; }
    }
    PG8_WAIT_V(0);
    if constexpr (!ALIGN_EPI) { if (wr == 0) PG8_BAR; }
    PG8_BAR;
    if constexpr (Epi::AFTER_DRAIN) { E.fused(acc, cur, wr, wc, fr, fq, lds, wid, lane); S.done(cur); }
#undef PG8_SA
#undef PG8_SB
#undef PG8_STAGE
#undef PG8_LDA
#undef PG8_LDB
#undef PG8_MMA
#undef PG8_WAIT_V
#undef PG8_WAIT_L
#undef PG8_BAR
#undef PG8_SCHED
}
}
#define GAS __attribute__((address_space(1)))
#define LAS __attribute__((address_space(3)))
typedef unsigned short bf16;
typedef unsigned v4u __attribute__((ext_vector_type(4)));
typedef float f32x4 __attribute__((ext_vector_type(4)));
typedef short bf16x8 __attribute__((ext_vector_type(8)));
typedef GAS unsigned gu32;
typedef GAS unsigned long long gu64;
#define RLX_AGENT __ATOMIC_RELAXED, __HIP_MEMORY_SCOPE_AGENT
#define LDS_WAIT() asm volatile("s_waitcnt lgkmcnt(0)" ::: "memory")
#define VM_WAIT() asm volatile("s_waitcnt vmcnt(0)" ::: "memory")
__device__ __forceinline__ unsigned long long rt() { return __builtin_amdgcn_s_memrealtime(); }
__device__ __forceinline__ unsigned f2bf(float f) { unsigned u = __builtin_bit_cast(unsigned, f); return (u + 0x7fffu + ((u >> 16) & 1u)) >> 16; }
__device__ __forceinline__ unsigned pk2(float lo, float hi) { return f2bf(lo) | (f2bf(hi) << 16); }

#define XB_TMO      128
#define XB_XCNT(j)  (256  + 64 * (j))
#define XB_XSUB(j)  (1280 + 64 * (j))
#define XB_XGEN(j)  (2304 + 64 * (j))
#define XB_TOP      3328
#define XB_TOPGEN   3392
#define XCD_BAR_WORDS 3456
#define XB_SPIN_CAP (1u << 22)

__device__ __forceinline__ unsigned xb_ld(unsigned* p)              { return __hip_atomic_load(p, __ATOMIC_RELAXED, __HIP_MEMORY_SCOPE_AGENT); }
__device__ __forceinline__ unsigned xb_add(unsigned* p, unsigned v) { return __hip_atomic_fetch_add(p, v, __ATOMIC_RELAXED, __HIP_MEMORY_SCOPE_AGENT); }
__device__ __forceinline__ unsigned xb_xcc_id() { return (unsigned)__builtin_amdgcn_s_getreg((3 << 11) | 20) & 0xFu; }
#define XB_SPIN(cond, bar) do { unsigned _sp = 0; while (cond) { __builtin_amdgcn_s_sleep(1); \
    if ((++_sp & 255u) == 0u) { if (xb_ld(&(bar)[XB_TMO])) break; if (_sp > XB_SPIN_CAP) { atomicAdd(&(bar)[XB_TMO], 1u); break; } } } } while (0)

struct XcdBarrier {
    unsigned* bar; unsigned x;
    volatile LAS unsigned* st;
};

__device__ __forceinline__ XcdBarrier xcd_barrier_post(unsigned* bar, volatile LAS unsigned* st) {
    XcdBarrier b; b.bar = bar; b.x = xb_xcc_id(); b.st = st;
    if (threadIdx.x == 0) (void)xb_add(&bar[XB_XCNT(b.x)], 1u);
    return b;
}
__device__ __forceinline__ void xcd_barrier_complete(unsigned* bar, unsigned x, unsigned& nloc, unsigned& nx) {
    const unsigned G = gridDim.x * gridDim.y * gridDim.z;
    unsigned sum, cnt, mine, sp = 0u;
    for (;;) {
        sum = 0u; cnt = 0u; mine = 0u;
#pragma unroll
        for (unsigned j = 0; j < 16; ++j) { const unsigned c = xb_ld(&bar[XB_XCNT(j)]); sum += c; cnt += (c > 0u) ? 1u : 0u; mine = (j == x) ? c : mine; }
        if (sum == G) break;
        __builtin_amdgcn_s_sleep(1);
        if ((++sp & 255u) == 0u) { if (xb_ld(&bar[XB_TMO])) break; if (sp > XB_SPIN_CAP) { atomicAdd(&bar[XB_TMO], 1u); break; } }
    }
    nloc = mine > 0u ? mine : 1u; nx = cnt > 0u ? cnt : 1u;
}

__device__ __forceinline__ void xcd_barrier(const XcdBarrier& b) {
    asm volatile("s_waitcnt vmcnt(0)" ::: "memory");
    __syncthreads();
    if (threadIdx.x == 0) {
        unsigned* bar = b.bar;
        __builtin_amdgcn_s_waitcnt(0);
        unsigned nloc = b.st[0], nx = b.st[1];
        if (nloc == 0u) { xcd_barrier_complete(bar, b.x, nloc, nx); b.st[0] = nloc; b.st[1] = nx; }
        const unsigned old = xb_add(&bar[XB_XSUB(b.x)], 1u);
        const unsigned gen = old / nloc;
        if (old + 1u == (gen + 1u) * nloc) {
            __builtin_amdgcn_fence(__ATOMIC_RELEASE, "agent");
            asm volatile("s_waitcnt vmcnt(0)" ::: "memory");
            const unsigned og = xb_add(&bar[XB_TOP], 1u);
            const unsigned tg = og / nx;
            if (og + 1u == (tg + 1u) * nx) xb_add(&bar[XB_TOPGEN], 1u);
            else XB_SPIN(xb_ld(&bar[XB_TOPGEN]) == tg, bar);
            __builtin_amdgcn_fence(__ATOMIC_ACQUIRE, "agent");
            xb_add(&bar[XB_XGEN(b.x)], 1u);
            asm volatile("s_waitcnt vmcnt(0)" ::: "memory");
        } else {
            XB_SPIN(xb_ld(&bar[XB_XGEN(b.x)]) == gen, bar);
            __builtin_amdgcn_fence(__ATOMIC_ACQUIRE, "agent");
            asm volatile("s_waitcnt vmcnt(0)" ::: "memory");
        }
    }
    __syncthreads();
}

constexpr int NWAVES = 8;
constexpr int BATCH = 16, SEQ = 2048, DM = 1024, T = BATCH * SEQ, MEM = 256, TM = BATCH * MEM;
constexpr int INC = 10768;
constexpr int NT1 = 31, NTG = 12, NTKV = 8;
constexpr int WT_ROWS = (NT1 + NTG + NTKV) * 256;
constexpr float EPS = 1e-6f;
#ifndef GLA_MFMA
#define GLA_MFMA 1
#endif
#ifndef SWA_MFMA
#define SWA_MFMA 1
#endif
#ifndef XAT_MFMA
#define XAT_MFMA 1
#endif
#ifndef MK_N_LAUNCHES
#define MK_N_LAUNCHES 1
#endif
constexpr int N_PHASES = 9;
constexpr int N_LAUNCHES = MK_N_LAUNCHES;

constexpr size_t MiB = 1u << 20;
constexpr size_t WS_CTL = 0, CTL_ZERO_BYTES = 1 * MiB;
constexpr size_t CTL_ROWSS = 512 * 1024;
constexpr size_t WS_WT = 2 * MiB;
constexpr size_t WS_WBR = 28 * MiB;
constexpr size_t WS_WOUT = 34 * MiB;
constexpr size_t WS_RSTD = 36 * MiB;
constexpr size_t WS_BIAS = 36 * MiB + 256 * 1024;
constexpr size_t WS_COS = 36 * MiB + 512 * 1024, WS_SIN = 36 * MiB + 768 * 1024;
constexpr size_t WS_GLR = 37 * MiB;
constexpr size_t WS_Z = 40 * MiB;
constexpr size_t WS_GQ = 232 * MiB, WS_GK = 264 * MiB, WS_GV = 296 * MiB, WS_SQ = 360 * MiB, WS_XQ = 424 * MiB;
constexpr size_t WS_GATES = 232 * MiB, WS_MERGED = 424 * MiB;
constexpr size_t WS_END = 488 * MiB;
constexpr size_t DO_XB = 0, DO_SK = 72 * MiB, DO_SV = 88 * MiB, DO_MKV = 104 * MiB;
constexpr int CW_BAR = 4096, CW_QUEUE = 2048;

constexpr int LDS_BYTES = 159744;
constexpr int MISC_OFF = 158720;

__device__ __forceinline__ float bf2f(bf16 h) { return __builtin_bit_cast(float, (unsigned)h << 16); }
__device__ __forceinline__ float wave_sum(float v) {
#pragma unroll
    for (int o = 1; o < 64; o <<= 1) v += __shfl_xor(v, o);
    return v;
}
__device__ __forceinline__ float wave_max(float v) {
#pragma unroll
    for (int o = 1; o < 64; o <<= 1) v = fmaxf(v, __shfl_xor(v, o));
    return v;
}
__device__ const double INVF[32] = {1.0, 0.7498942093324559, 0.5623413251903491, 0.4216965034285822, 0.31622776601683794, 0.23713737056616552, 0.1778279410038923, 0.1333521432163324, 0.1, 0.07498942093324558,
    0.05623413251903491, 0.042169650342858224, 0.03162277660168379, 0.023713737056616554, 0.01778279410038923, 0.01333521432163324, 0.01, 0.007498942093324558, 0.005623413251903491, 0.004216965034285823,
    0.0031622776601683794, 0.0023713737056616554, 0.0017782794100389228, 0.001333521432163324, 0.001, 0.0007498942093324559, 0.0005623413251903491, 0.00042169650342858224, 0.00031622776601683794,
    0.00023713737056616554, 0.00017782794100389227, 0.0001333521432163324};
__device__ __forceinline__ void sincos_d(double x, float& c, float& s) {
    const double kq = __builtin_rint(x * 0.6366197723675814);
    const double r = (x - kq * 1.5707963267341256) - kq * 6.077094383272197e-11, r2 = r * r;
    const double sr = r + r * r2 * (-1.0 / 6 + r2 * (1.0 / 120 + r2 * (-1.0 / 5040 + r2 * (1.0 / 362880 + r2 * (-1.0 / 39916800 + r2 * (1.0 / 6227020800.0))))));
    const double cr = 1.0 + r2 * (-0.5 + r2 * (1.0 / 24 + r2 * (-1.0 / 720 + r2 * (1.0 / 40320 + r2 * (-1.0 / 3628800 + r2 * (1.0 / 479001600.0))))));
    const int q = (int)kq & 3;
    const double cc = (q == 0) ? cr : (q == 1) ? -sr : (q == 2) ? -cr : sr;
    const double ss = (q == 0) ? sr : (q == 1) ? cr : (q == 2) ? -sr : -cr;
    c = (float)cc; s = (float)ss;
}

struct Frame {
    LAS unsigned char* lds; int tid, lane, wave, vcu, G;
    const float *x, *mem, *g_mix, *g_mem, *w_in, *b_in, *w_up, *b_gate, *g_gnorm, *sinks, *w_mem_kv, *w_br_gla, *w_br_swa, *w_br_mem, *w_out, *g_final;
    float* out; gu32* ctl;
    bf16 *WT, *WBR, *WOUT, *XB, *Z, *GQ, *GK, *GV, *SQ, *SK, *SV, *XQ, *GATES, *MERGED, *MKV;
    float *RSTD, *BIAS, *COS, *SIN, *GLR, *ROWSS;
};

__device__ __forceinline__ int srccol(int t) { return t < 12 ? t * 256 : t < 30 ? 3088 + (t - 12) * 256 : t == 30 ? 3072 : 7696 + (t - 31) * 256; }
__device__ __forceinline__ void tr_item(const float* W, int ldw, int k0, int scol0, int nvalid, const float* ks, int ksmask, bf16* dst, int ldd, int drow0, int dk0, LAS float* scr, int lane) {
#pragma unroll 8
    for (int i = 0; i < 32; ++i) { const int kk = 2 * i + (lane >> 5), n = lane & 31; float v = 0.f;
        if (n < nvalid) { v = W[(size_t)(k0 + kk) * ldw + scol0 + n]; if (ks) v *= ks[(k0 + kk) & ksmask]; }
        scr[kk * 33 + n] = v; }
    LDS_WAIT(); asm volatile("" ::: "memory");
    const int c = lane & 7;
#pragma unroll
    for (int j = 0; j < 4; ++j) { const int n = (lane >> 3) + 8 * j; const LAS float* s = scr + (8 * c) * 33 + n;
        v4u o; o.x = pk2(s[0 * 33], s[1 * 33]); o.y = pk2(s[2 * 33], s[3 * 33]); o.z = pk2(s[4 * 33], s[5 * 33]); o.w = pk2(s[6 * 33], s[7 * 33]);
        *(GAS v4u*)(dst + (size_t)(drow0 + n) * ldd + dk0 + k0 + 8 * c) = o; }
    LDS_WAIT(); asm volatile("" ::: "memory");
}
__device__ __forceinline__ void p0_prologue(Frame& F) {
    LAS float* scr = (LAS float*)(F.lds + F.wave * 16384);
    const int gw = F.vcu * NWAVES + F.wave, NGW = F.G * NWAVES;
    constexpr int NB_IN = (NT1 + NTG) * 8, NB_KV = 64, NB_BR = 96, NB_OUT = 32, NB = NB_IN + NB_KV + NB_BR + NB_OUT;
    for (int it = gw; it < NB * 16; it += NGW) {
        const int kb = it / NB, nb = it % NB, k0 = kb * 64;
        if (nb < NB_IN) { const int tile = nb >> 3, j = nb & 7; const int nvalid = (tile == 30) ? (j == 0 ? 16 : 0) : 32;
            tr_item(F.w_in, INC, k0, srccol(tile) + j * 32, nvalid, F.g_mix, 1023, F.WT, 1024, nb * 32, 0, scr, F.lane); }
        else if (nb < NB_IN + NB_KV) { const int n0 = (nb - NB_IN) * 32; tr_item(F.w_mem_kv, 2048, k0, n0, 32, F.g_mem, 1023, F.WT, 1024, (NT1 + NTG) * 256 + n0, 0, scr, F.lane); }
        else if (nb < NB_IN + NB_KV + NB_BR) { const int r = nb - NB_IN - NB_KV, s = r >> 5, n0 = (r & 31) * 32;
            if (s == 0) tr_item(F.w_br_gla, 1024, k0, n0, 32, F.g_gnorm, 255, F.WBR, 3072, n0, 0, scr, F.lane);
            else if (s == 1) tr_item(F.w_br_swa, 1024, k0, n0, 32, nullptr, 255, F.WBR, 3072, n0, 1024, scr, F.lane);
            else tr_item(F.w_br_mem, 1024, k0, n0, 32, nullptr, 255, F.WBR, 3072, n0, 2048, scr, F.lane); }
        else { const int n0 = (nb - NB_IN - NB_KV - NB_BR) * 32; tr_item(F.w_out, 1024, k0, n0, 32, nullptr, 0, F.WOUT, 1024, n0, 0, scr, F.lane); }
    }
    for (int m = gw; m < T + TM; m += NGW) {
        const float* src = m < T ? F.x + (size_t)m * DM : F.mem + (size_t)(m - T) * DM;
        const GAS f32x4* xr = (const GAS f32x4*)src + F.lane;
        f32x4 v[4]; float s = 0.f;
#pragma unroll
        for (int j = 0; j < 4; ++j) { v[j] = xr[64 * j]; s += (v[j].x * v[j].x + v[j].y * v[j].y) + (v[j].z * v[j].z + v[j].w * v[j].w); }
        const float rstd = 1.f / sqrtf(wave_sum(s) * (1.f / DM) + EPS);
        if (F.lane == 0) F.RSTD[m] = rstd;
        GAS unsigned long long* o8 = (GAS unsigned long long*)(F.XB + (size_t)m * DM) + F.lane;
#pragma unroll
        for (int j = 0; j < 4; ++j) o8[64 * j] = (unsigned long long)pk2(v[j].x, v[j].y) | ((unsigned long long)pk2(v[j].z, v[j].w) << 32);
    }
    const int gt = F.vcu * (NWAVES * 64) + F.tid, NGT = F.G * NWAVES * 64;
    for (int i = gt; i < WT_ROWS; i += NGT) { float b = 0.f;
        if (i < (NT1 + NTG) * 256) { const int tile = i >> 8, j = i & 255; if (tile != 30 || j < 16) b = F.b_in[srccol(tile) + j]; }
        F.BIAS[i] = b; }
    for (int i = gt; i < SEQ * 32; i += NGT) { float c, s; sincos_d((double)(i >> 5) * INVF[i & 31], c, s); F.COS[i] = c; F.SIN[i] = s; }
}

__device__ __forceinline__ void gla_naive_unit(Frame& F, int b, int h) {
    LAS float* sq = (LAS float*)F.lds; LAS float* sk = sq + 8192; LAS float* sa = sk + 8192;
    LAS bf16* sv = (LAS bf16*)(sa + 8192);
    LAS float* sg = (LAS float*)(F.lds + 131072); LAS float* pos = sg + 1024; LAS float* red = pos + 512;
    const int tid = F.tid, dv = tid & 255, dh = tid >> 8;
    float S[64];
#pragma unroll
    for (int i = 0; i < 64; ++i) S[i] = 0.f;
    for (int c = 0; c < SEQ / 64; ++c) {
        const size_t row0 = (size_t)b * SEQ + c * 64;
        for (int i = tid; i < 1024; i += 512) sg[i] = F.GLR[row0 * 16 + i];
        for (int i = tid; i < 64 * 32; i += 512) { const int tok = i >> 5, c8 = i & 31;
            *(LAS v4u*)(sv + tok * 256 + c8 * 8) = *(const GAS v4u*)(F.GV + (row0 + tok) * 1024 + h * 256 + c8 * 8); }
        __syncthreads();
        for (int i = tid; i < 8192; i += 512) { const int tok = i >> 7, d = i & 127;
            float z = F.b_gate[h * 128 + d];
#pragma unroll
            for (int r = 0; r < 16; ++r) z += sg[tok * 16 + r] * F.w_up[r * 512 + h * 128 + d];
            const float ls = fminf(z, 0.f) - log1pf(expf(-fabsf(z)));
            sa[i] = expf(ls * 0.0625f);
            sq[i] = bf2f(F.GQ[(row0 + tok) * 512 + h * 128 + d]) * 0.08838834764831845f;
            sk[i] = bf2f(F.GK[(row0 + tok) * 512 + h * 128 + d]); }
        __syncthreads();
        for (int tok = 0; tok < 64; ++tok) {
            const float vv = bf2f(sv[tok * 256 + dv]); float po = 0.f;
            const LAS float* pa = sa + tok * 128 + dh * 64; const LAS float* pk = sk + tok * 128 + dh * 64; const LAS float* pq = sq + tok * 128 + dh * 64;
#pragma unroll
            for (int i = 0; i < 64; ++i) { S[i] = pa[i] * S[i] + pk[i] * vv; po += pq[i] * S[i]; }
            pos[dh * 256 + dv] = po;
            __syncthreads();
            float o = 0.f;
            if (tid < 256) { o = pos[dv] + pos[256 + dv]; const float ss = wave_sum(o * o); if (F.lane == 0) red[F.wave] = ss; }
            __syncthreads();
            if (tid < 256) { const float tot = (red[0] + red[1]) + (red[2] + red[3]); const float rstd = 1.f / sqrtf(tot * (1.f / 256.f) + EPS);
                bf16* zp = F.Z + (row0 + tok) * 3072 + h * 256 + dv; *zp = (bf16)f2bf(o * rstd * bf2f(*zp)); }
        }
        __syncthreads();
    }
}
__device__ __forceinline__ void swa_naive_unit(Frame& F, int b, int nblk, int g) {
    LAS float* Ks = (LAS float*)F.lds; LAS float* Vs = Ks + 256 * 65; LAS float* qs = Vs + 256 * 65; LAS float* ps = qs + 512;
    const int tid = F.tid, lane = F.lane, w = F.wave;
    for (int i = tid; i < 256 * 32; i += 512) { const int j = i >> 5, ii = i & 31, kp = (nblk - 1) * 128 + j; float a = 0.f, bb = 0.f;
        if (kp >= 0) { const size_t row = (size_t)b * SEQ + kp; const float x1 = bf2f(F.SK[row * 256 + g * 64 + ii]), x2 = bf2f(F.SK[row * 256 + g * 64 + ii + 32]);
            const float c = F.COS[kp * 32 + ii], s = F.SIN[kp * 32 + ii]; a = x1 * c - x2 * s; bb = x2 * c + x1 * s; }
        Ks[j * 65 + ii] = a; Ks[j * 65 + ii + 32] = bb; }
    for (int i = tid; i < 256 * 64; i += 512) { const int j = i >> 6, d = i & 63, kp = (nblk - 1) * 128 + j;
        Vs[j * 65 + d] = kp >= 0 ? bf2f(F.SV[((size_t)b * SEQ + kp) * 256 + g * 64 + d]) : 0.f; }
    __syncthreads();
    const int hq = g * 4 + (w >> 1), tbase = (w & 1) * 64; const float sink = F.sinks[hq];
    for (int r = 0; r < 64; ++r) {
        const int ti = tbase + r, p = nblk * 128 + ti; const size_t row = (size_t)b * SEQ + p;
        const float xv = bf2f(F.SQ[row * 1024 + hq * 64 + lane]), pr = __shfl_xor(xv, 32);
        const float c = F.COS[p * 32 + (lane & 31)], s = F.SIN[p * 32 + (lane & 31)];
        qs[w * 64 + lane] = lane < 32 ? xv * c - pr * s : xv * c + pr * s;
        asm volatile("s_waitcnt lgkmcnt(0)" ::: "memory");
        float sc[4]; bool valid[4]; float mx = sink;
#pragma unroll
        for (int jj = 0; jj < 4; ++jj) { const int j = lane + 64 * jj, kp = (nblk - 1) * 128 + j; valid[jj] = (kp <= p) && (kp > p - 128) && (kp >= 0);
            float acc = 0.f;
            for (int d = 0; d < 64; ++d) acc += qs[w * 64 + d] * Ks[j * 65 + d];
            sc[jj] = acc * 0.125f; if (valid[jj]) mx = fmaxf(mx, sc[jj]); }
        mx = wave_max(mx);
        float sum = 0.f, pj[4];
#pragma unroll
        for (int jj = 0; jj < 4; ++jj) { pj[jj] = valid[jj] ? __expf(sc[jj] - mx) : 0.f; sum += pj[jj]; }
        sum = wave_sum(sum) + __expf(sink - mx);
        const float inv = 1.f / sum;
#pragma unroll
        for (int jj = 0; jj < 4; ++jj) ps[w * 256 + lane + 64 * jj] = pj[jj] * inv;
        asm volatile("s_waitcnt lgkmcnt(0)" ::: "memory");
        float o = 0.f;
        for (int j = 0; j < 256; ++j) o += ps[w * 256 + j] * Vs[j * 65 + lane];
        bf16* zp = F.Z + row * 3072 + 1024 + hq * 64 + lane; *zp = (bf16)f2bf(o * bf2f(*zp));
        asm volatile("" ::: "memory");
    }
    __syncthreads();
}
__device__ __forceinline__ void xat_naive_unit(Frame& F, int b, int h, int qb) {
    LAS bf16* Ks = (LAS bf16*)F.lds;
    LAS float* scr = (LAS float*)(F.lds + 132096) + F.wave * 512;
    const int tid = F.tid, lane = F.lane, w = F.wave;
    for (int i = tid; i < 256 * 32; i += 512) { const int m = i >> 5, c8 = i & 31;
        const v4u v = *(const GAS v4u*)(F.MKV + ((size_t)b * MEM + m) * 2048 + h * 256 + c8 * 8);
        LAS unsigned* d = (LAS unsigned*)(Ks + m * 258 + c8 * 8); d[0] = v.x; d[1] = v.y; d[2] = v.z; d[3] = v.w; }
    __syncthreads();
    for (int it = 0; it < 16; ++it) {
        const size_t row = (size_t)b * SEQ + qb * 256 + w * 32 + it * 2;
#pragma unroll
        for (int rr = 0; rr < 2; ++rr) { const unsigned long long q4 = *(const GAS unsigned long long*)(F.XQ + (row + rr) * 1024 + h * 256 + lane * 4);
            const unsigned lo = (unsigned)q4, hi = (unsigned)(q4 >> 32);
            scr[rr * 256 + lane * 4 + 0] = pg8::bflo(lo) * 0.0625f; scr[rr * 256 + lane * 4 + 1] = pg8::bfhi(lo) * 0.0625f;
            scr[rr * 256 + lane * 4 + 2] = pg8::bflo(hi) * 0.0625f; scr[rr * 256 + lane * 4 + 3] = pg8::bfhi(hi) * 0.0625f; }
        asm volatile("s_waitcnt lgkmcnt(0)" ::: "memory");
        float acc[2][4];
#pragma unroll
        for (int rr = 0; rr < 2; ++rr)
#pragma unroll
            for (int jj = 0; jj < 4; ++jj) acc[rr][jj] = 0.f;
        for (int d2 = 0; d2 < 128; ++d2) {
            const float q00 = scr[2 * d2], q01 = scr[2 * d2 + 1], q10 = scr[256 + 2 * d2], q11 = scr[256 + 2 * d2 + 1];
#pragma unroll
            for (int jj = 0; jj < 4; ++jj) { const unsigned kw = *(const LAS unsigned*)(Ks + (lane + 64 * jj) * 258 + 2 * d2);
                const float k0 = pg8::bflo(kw), k1 = pg8::bfhi(kw);
                acc[0][jj] += q00 * k0 + q01 * k1; acc[1][jj] += q10 * k0 + q11 * k1; }
        }
        asm volatile("" ::: "memory");
#pragma unroll
        for (int rr = 0; rr < 2; ++rr) {
            float mx = fmaxf(fmaxf(acc[rr][0], acc[rr][1]), fmaxf(acc[rr][2], acc[rr][3])); mx = wave_max(mx);
            float pj[4], sum = 0.f;
#pragma unroll
            for (int jj = 0; jj < 4; ++jj) { pj[jj] = __expf(acc[rr][jj] - mx); sum += pj[jj]; }
            const float inv = 1.f / wave_sum(sum);
#pragma unroll
            for (int jj = 0; jj < 4; ++jj) scr[rr * 256 + lane + 64 * jj] = pj[jj] * inv;
        }
        asm volatile("s_waitcnt lgkmcnt(0)" ::: "memory");
        float o[2][4];
#pragma unroll
        for (int rr = 0; rr < 2; ++rr)
#pragma unroll
            for (int e = 0; e < 4; ++e) o[rr][e] = 0.f;
        const bf16* vb = F.MKV + (size_t)b * MEM * 2048 + 1024 + h * 256 + lane * 4;
        for (int m = 0; m < 256; ++m) { const unsigned long long v4 = *(const GAS unsigned long long*)(vb + (size_t)m * 2048);
            const unsigned lo = (unsigned)v4, hi = (unsigned)(v4 >> 32); const float v0 = pg8::bflo(lo), v1 = pg8::bfhi(lo), v2 = pg8::bflo(hi), v3 = pg8::bfhi(hi);
            const float p0 = scr[m], p1 = scr[256 + m];
            o[0][0] += p0 * v0; o[0][1] += p0 * v1; o[0][2] += p0 * v2; o[0][3] += p0 * v3;
            o[1][0] += p1 * v0; o[1][1] += p1 * v1; o[1][2] += p1 * v2; o[1][3] += p1 * v3; }
#pragma unroll
        for (int rr = 0; rr < 2; ++rr) { GAS unsigned long long* zp = (GAS unsigned long long*)(F.Z + (row + rr) * 3072 + 2048 + h * 256 + lane * 4);
            const unsigned long long z4 = *zp; const unsigned lo = (unsigned)z4, hi = (unsigned)(z4 >> 32);
            *zp = (unsigned long long)pk2(o[rr][0] * pg8::bflo(lo), o[rr][1] * pg8::bfhi(lo)) | ((unsigned long long)pk2(o[rr][2] * pg8::bflo(hi), o[rr][3] * pg8::bfhi(hi)) << 32); }
        asm volatile("s_waitcnt lgkmcnt(0)" ::: "memory");
    }
    __syncthreads();
}

typedef short s16x4 __attribute__((ext_vector_type(4)));
typedef float f32x16 __attribute__((ext_vector_type(16)));
#define MFMA32(a, b, c) __builtin_amdgcn_mfma_f32_32x32x16_bf16((a), (b), (c), 0, 0, 0)
#define MFMA16(a, b, c) __builtin_amdgcn_mfma_f32_16x16x32_bf16((a), (b), (c), 0, 0, 0)
__device__ __forceinline__ int crow(int r, int hi) { return (r & 3) + 8 * (r >> 2) + 4 * hi; }
__device__ __forceinline__ s16x4 ds_tr(LAS unsigned char* p) { return __builtin_bit_cast(s16x4, __builtin_amdgcn_ds_read_tr16_b64_v4i16((LAS s16x4*)p)); }
__device__ __forceinline__ bf16x8 cat8(s16x4 a, s16x4 b) { return (bf16x8){a[0], a[1], a[2], a[3], b[0], b[1], b[2], b[3]}; }
__device__ __forceinline__ float xhalf(float v) { return __shfl_xor(v, 32); }
__device__ __forceinline__ bf16x8 pack_acc(const f32x16& p, int s) {
    v4u w; w.x = pg8::cvt_pk_bf16(p[8 * s + 0], p[8 * s + 1]); w.y = pg8::cvt_pk_bf16(p[8 * s + 2], p[8 * s + 3]); w.z = pg8::cvt_pk_bf16(p[8 * s + 4], p[8 * s + 5]); w.w = pg8::cvt_pk_bf16(p[8 * s + 6], p[8 * s + 7]);
    return __builtin_bit_cast(bf16x8, w);
}
__device__ __forceinline__ v4u mul8(v4u z, const float* o) {
    v4u r; r.x = pg8::cvt_pk_bf16(pg8::bflo(z.x) * o[0], pg8::bfhi(z.x) * o[1]); r.y = pg8::cvt_pk_bf16(pg8::bflo(z.y) * o[2], pg8::bfhi(z.y) * o[3]);
    r.z = pg8::cvt_pk_bf16(pg8::bflo(z.z) * o[4], pg8::bfhi(z.z) * o[5]); r.w = pg8::cvt_pk_bf16(pg8::bflo(z.w) * o[6], pg8::bfhi(z.w) * o[7]); return r;
}
__device__ __forceinline__ v4u mul8b(v4u z, v4u o) {
    v4u r; r.x = pg8::cvt_pk_bf16(pg8::bflo(z.x) * pg8::bflo(o.x), pg8::bfhi(z.x) * pg8::bfhi(o.x)); r.y = pg8::cvt_pk_bf16(pg8::bflo(z.y) * pg8::bflo(o.y), pg8::bfhi(z.y) * pg8::bfhi(o.y));
    r.z = pg8::cvt_pk_bf16(pg8::bflo(z.z) * pg8::bflo(o.z), pg8::bfhi(z.z) * pg8::bfhi(o.z)); r.w = pg8::cvt_pk_bf16(pg8::bflo(z.w) * pg8::bflo(o.w), pg8::bfhi(z.w) * pg8::bfhi(o.w)); return r;
}

__device__ __forceinline__ void xat_unit(Frame& F, int b, int h, int qb) {
    LAS unsigned char* L = F.lds; int tid_ = F.tid; asm volatile("" : "+v"(tid_));
    const int tid = tid_, lane = tid & 63, w = __builtin_amdgcn_readfirstlane(tid >> 6), r32 = lane & 31, hi = lane >> 5;
    const bf16* kvb = F.MKV + (size_t)b * MEM * 2048 + h * 256;
#pragma unroll 4
    for (int it = 0; it < 16; ++it) { const int idx = tid + 512 * it, m = idx >> 5, c = idx & 31;
        *(LAS v4u*)(L + c * 4096 + m * 16) = *(const GAS v4u*)(kvb + (size_t)m * 2048 + 8 * c); }
    const size_t row = (size_t)b * SEQ + qb * 256 + w * 32 + r32;
    const bf16* qp = F.XQ + row * 1024 + h * 256 + 8 * hi;
    bf16x8 qa = *(const GAS bf16x8*)qp, qc;
    __syncthreads();
    f32x16 P[8];
#pragma unroll
    for (int kt = 0; kt < 8; ++kt) P[kt] = (f32x16){0.f, 0.f, 0.f, 0.f, 0.f, 0.f, 0.f, 0.f, 0.f, 0.f, 0.f, 0.f, 0.f, 0.f, 0.f, 0.f};
#pragma unroll 1
    for (int s = 0; s < 16; s += 2) {
        qc = *(const GAS bf16x8*)(qp + 16 * (s + 1));
        { LAS unsigned char* kb = L + (2 * s + hi) * 4096 + r32 * 16;
#pragma unroll
          for (int kt = 0; kt < 8; ++kt) { const bf16x8 a = *(const LAS bf16x8*)(kb + kt * 512); P[kt] = MFMA32(a, qa, P[kt]); } }
        if (s + 2 < 16) qa = *(const GAS bf16x8*)(qp + 16 * (s + 2));
        { LAS unsigned char* kb = L + (2 * s + 2 + hi) * 4096 + r32 * 16;
#pragma unroll
          for (int kt = 0; kt < 8; ++kt) { const bf16x8 a = *(const LAS bf16x8*)(kb + kt * 512); P[kt] = MFMA32(a, qc, P[kt]); } }
    }
    constexpr float C2 = 0.0625f * 1.4426950408889634f;
    float mx = P[0][0];
#pragma unroll
    for (int kt = 0; kt < 8; ++kt)
#pragma unroll
        for (int r = 0; r < 16; ++r) mx = fmaxf(mx, P[kt][r]);
    mx = fmaxf(mx, xhalf(mx));
    const float mc = mx * C2; float sum = 0.f;
#pragma unroll
    for (int kt = 0; kt < 8; ++kt)
#pragma unroll
        for (int r = 0; r < 16; ++r) { const float e = __builtin_amdgcn_exp2f(P[kt][r] * C2 - mc); P[kt][r] = e; sum += e; }
    sum += xhalf(sum);
    const float inv = 1.f / sum;
    bf16x8 pf[8][2];
#pragma unroll
    for (int kt = 0; kt < 8; ++kt) {
#pragma unroll
        for (int r = 0; r < 16; ++r) P[kt][r] *= inv;
        pf[kt][0] = pack_acc(P[kt], 0); pf[kt][1] = pack_acc(P[kt], 1); }
    __syncthreads();
#pragma unroll 4
    for (int it = 0; it < 16; ++it) { const int idx = tid + 512 * it, m = idx >> 5, c = idx & 31;
        *(LAS v4u*)(L + (c >> 2) * 16384 + m * 64 + (c & 3) * 16) = *(const GAS v4u*)(kvb + 1024 + (size_t)m * 2048 + 8 * c); }
    __syncthreads();
    LAS unsigned char* st = L + 131072 + w * 2560;
    const int vlane = (4 * hi + ((lane & 15) >> 2)) * 64 + ((lane >> 4) & 1) * 32 + (lane & 3) * 8;
    const size_t orow = (size_t)b * SEQ + qb * 256 + w * 32;
#pragma unroll 1
    for (int dt = 0; dt < 8; ++dt) {
        f32x16 O = (f32x16){0.f, 0.f, 0.f, 0.f, 0.f, 0.f, 0.f, 0.f, 0.f, 0.f, 0.f, 0.f, 0.f, 0.f, 0.f, 0.f};
        LAS unsigned char* vb = L + dt * 16384 + vlane;
#pragma unroll
        for (int kt = 0; kt < 8; ++kt)
#pragma unroll
            for (int s2 = 0; s2 < 2; ++s2) { const s16x4 v0 = ds_tr(vb + (32 * kt + 16 * s2) * 64), v1 = ds_tr(vb + (32 * kt + 16 * s2 + 8) * 64); O = MFMA32(pf[kt][s2], cat8(v0, v1), O); }
#pragma unroll
        for (int r = 0; r < 16; ++r) *(LAS bf16*)(st + crow(r, hi) * 80 + r32 * 2) = (bf16)f2bf(O[r]);
        asm volatile("s_waitcnt lgkmcnt(0)" ::: "memory");
#pragma unroll
        for (int i = 0; i < 2; ++i) { const int rq = i * 16 + (lane >> 2), ch = lane & 3;
            const v4u o = *(const LAS v4u*)(st + rq * 80 + ch * 16);
            GAS v4u* zp = (GAS v4u*)(F.Z + (orow + rq) * 3072 + 2048 + h * 256 + 32 * dt + 8 * ch);
            *zp = mul8b(*zp, o); }
        asm volatile("s_waitcnt lgkmcnt(0)" ::: "memory");
    }
    __syncthreads();
}

__device__ __forceinline__ void swa_unit(Frame& F, int b, int nblk, int g) {
    LAS unsigned char* L = F.lds; int tid_ = F.tid; asm volatile("" : "+v"(tid_));
    const int tid = tid_, lane = tid & 63, w = __builtin_amdgcn_readfirstlane(tid >> 6), r32 = lane & 31, hi = lane >> 5;
    constexpr int S_V = 32768, S_ST = 65536;
#pragma unroll
    for (int it = 0; it < 2; ++it) { const int idx = tid + 512 * it, j = idx >> 2, c = idx & 3, kp = (nblk - 1) * 128 + j;
        v4u o1 = (v4u){0u, 0u, 0u, 0u}, o2 = o1;
        if (kp >= 0) { const bf16* kr = F.SK + ((size_t)b * SEQ + kp) * 256 + g * 64 + 8 * c;
            const v4u x1 = *(const GAS v4u*)kr, x2 = *(const GAS v4u*)(kr + 32);
            const f32x4 c0 = *(const GAS f32x4*)(F.COS + kp * 32 + 8 * c), c1 = *(const GAS f32x4*)(F.COS + kp * 32 + 8 * c + 4);
            const f32x4 s0 = *(const GAS f32x4*)(F.SIN + kp * 32 + 8 * c), s1 = *(const GAS f32x4*)(F.SIN + kp * 32 + 8 * c + 4);
            const float a[8] = {pg8::bflo(x1.x), pg8::bfhi(x1.x), pg8::bflo(x1.y), pg8::bfhi(x1.y), pg8::bflo(x1.z), pg8::bfhi(x1.z), pg8::bflo(x1.w), pg8::bfhi(x1.w)};
            const float bb[8] = {pg8::bflo(x2.x), pg8::bfhi(x2.x), pg8::bflo(x2.y), pg8::bfhi(x2.y), pg8::bflo(x2.z), pg8::bfhi(x2.z), pg8::bflo(x2.w), pg8::bfhi(x2.w)};
            const float cs[8] = {c0[0], c0[1], c0[2], c0[3], c1[0], c1[1], c1[2], c1[3]}, sn[8] = {s0[0], s0[1], s0[2], s0[3], s1[0], s1[1], s1[2], s1[3]};
            o1.x = pg8::cvt_pk_bf16(a[0] * cs[0] - bb[0] * sn[0], a[1] * cs[1] - bb[1] * sn[1]); o1.y = pg8::cvt_pk_bf16(a[2] * cs[2] - bb[2] * sn[2], a[3] * cs[3] - bb[3] * sn[3]);
            o1.z = pg8::cvt_pk_bf16(a[4] * cs[4] - bb[4] * sn[4], a[5] * cs[5] - bb[5] * sn[5]); o1.w = pg8::cvt_pk_bf16(a[6] * cs[6] - bb[6] * sn[6], a[7] * cs[7] - bb[7] * sn[7]);
            o2.x = pg8::cvt_pk_bf16(bb[0] * cs[0] + a[0] * sn[0], bb[1] * cs[1] + a[1] * sn[1]); o2.y = pg8::cvt_pk_bf16(bb[2] * cs[2] + a[2] * sn[2], bb[3] * cs[3] + a[3] * sn[3]);
            o2.z = pg8::cvt_pk_bf16(bb[4] * cs[4] + a[4] * sn[4], bb[5] * cs[5] + a[5] * sn[5]); o2.w = pg8::cvt_pk_bf16(bb[6] * cs[6] + a[6] * sn[6], bb[7] * cs[7] + a[7] * sn[7]); }
        *(LAS v4u*)(L + c * 4096 + j * 16) = o1; *(LAS v4u*)(L + (c + 4) * 4096 + j * 16) = o2; }
#pragma unroll
    for (int it = 0; it < 4; ++it) { const int idx = tid + 512 * it, j = idx >> 3, c = idx & 7, kp = (nblk - 1) * 128 + j;
        v4u v = (v4u){0u, 0u, 0u, 0u}; if (kp >= 0) v = *(const GAS v4u*)(F.SV + ((size_t)b * SEQ + kp) * 256 + g * 64 + 8 * c);
        *(LAS v4u*)(L + S_V + (c >> 2) * 16384 + j * 64 + (c & 3) * 16) = v; }
    __syncthreads();
    const int hq = g * 4 + (w >> 1), th = w & 1;
    constexpr float LOG2E = 1.4426950408889634f, QS = 0.125f * LOG2E;
    const float sink2 = F.sinks[hq] * LOG2E;
    LAS unsigned char* st = L + S_ST + w * 4608;
    const int vlane = (4 * hi + ((lane & 15) >> 2)) * 64 + ((lane >> 4) & 1) * 32 + (lane & 3) * 8;
#pragma unroll 1
    for (int rb = 0; rb < 2; ++rb) {
        const int t0 = th * 64 + rb * 32, p = nblk * 128 + t0 + r32; const size_t row = (size_t)b * SEQ + p;
        bf16x8 qf[4];
        { v4u x[4];
#pragma unroll
          for (int s = 0; s < 4; ++s) x[s] = *(const GAS v4u*)(F.SQ + row * 1024 + hq * 64 + 16 * s + 8 * hi);
#pragma unroll
          for (int s = 0; s < 2; ++s) {
            const f32x4 c0 = *(const GAS f32x4*)(F.COS + p * 32 + 16 * s + 8 * hi), c1 = *(const GAS f32x4*)(F.COS + p * 32 + 16 * s + 8 * hi + 4);
            const f32x4 s0 = *(const GAS f32x4*)(F.SIN + p * 32 + 16 * s + 8 * hi), s1 = *(const GAS f32x4*)(F.SIN + p * 32 + 16 * s + 8 * hi + 4);
            const v4u x1 = x[s], x2 = x[s + 2];
            const float a[8] = {pg8::bflo(x1.x), pg8::bfhi(x1.x), pg8::bflo(x1.y), pg8::bfhi(x1.y), pg8::bflo(x1.z), pg8::bfhi(x1.z), pg8::bflo(x1.w), pg8::bfhi(x1.w)};
            const float bb[8] = {pg8::bflo(x2.x), pg8::bfhi(x2.x), pg8::bflo(x2.y), pg8::bfhi(x2.y), pg8::bflo(x2.z), pg8::bfhi(x2.z), pg8::bflo(x2.w), pg8::bfhi(x2.w)};
            const float cs[8] = {c0[0] * QS, c0[1] * QS, c0[2] * QS, c0[3] * QS, c1[0] * QS, c1[1] * QS, c1[2] * QS, c1[3] * QS};
            const float sn[8] = {s0[0] * QS, s0[1] * QS, s0[2] * QS, s0[3] * QS, s1[0] * QS, s1[1] * QS, s1[2] * QS, s1[3] * QS};
            v4u o1, o2;
            o1.x = pg8::cvt_pk_bf16(a[0] * cs[0] - bb[0] * sn[0], a[1] * cs[1] - bb[1] * sn[1]); o1.y = pg8::cvt_pk_bf16(a[2] * cs[2] - bb[2] * sn[2], a[3] * cs[3] - bb[3] * sn[3]);
            o1.z = pg8::cvt_pk_bf16(a[4] * cs[4] - bb[4] * sn[4], a[5] * cs[5] - bb[5] * sn[5]); o1.w = pg8::cvt_pk_bf16(a[6] * cs[6] - bb[6] * sn[6], a[7] * cs[7] - bb[7] * sn[7]);
            o2.x = pg8::cvt_pk_bf16(bb[0] * cs[0] + a[0] * sn[0], bb[1] * cs[1] + a[1] * sn[1]); o2.y = pg8::cvt_pk_bf16(bb[2] * cs[2] + a[2] * sn[2], bb[3] * cs[3] + a[3] * sn[3]);
            o2.z = pg8::cvt_pk_bf16(bb[4] * cs[4] + a[4] * sn[4], bb[5] * cs[5] + a[5] * sn[5]); o2.w = pg8::cvt_pk_bf16(bb[6] * cs[6] + a[6] * sn[6], bb[7] * cs[7] + a[7] * sn[7]);
            qf[s] = __builtin_bit_cast(bf16x8, o1); qf[s + 2] = __builtin_bit_cast(bf16x8, o2); } }
        const int kt0 = t0 >> 5;
        f32x16 P[5];
#pragma unroll
        for (int t = 0; t < 5; ++t) {
            P[t] = (f32x16){0.f, 0.f, 0.f, 0.f, 0.f, 0.f, 0.f, 0.f, 0.f, 0.f, 0.f, 0.f, 0.f, 0.f, 0.f, 0.f};
#pragma unroll
            for (int s = 0; s < 4; ++s) { const bf16x8 a = *(const LAS bf16x8*)(L + (2 * s + hi) * 4096 + (32 * (kt0 + t) + r32) * 16); P[t] = MFMA32(a, qf[s], P[t]); }
        }
        const float NEG = -INFINITY;
#pragma unroll
        for (int r = 0; r < 16; ++r) { const int kr = crow(r, hi); if (!(kr > r32)) P[0][r] = NEG; if (!(kr <= r32)) P[4][r] = NEG; }
        if (nblk == 0) {
#pragma unroll
            for (int t = 0; t < 4; ++t) if (kt0 + t < 4) {
#pragma unroll
                for (int r = 0; r < 16; ++r) P[t][r] = NEG; }
        }
        float mx = sink2;
#pragma unroll
        for (int t = 0; t < 5; ++t)
#pragma unroll
            for (int r = 0; r < 16; ++r) mx = fmaxf(mx, P[t][r]);
        mx = fmaxf(mx, xhalf(mx));
        float sum = 0.f;
#pragma unroll
        for (int t = 0; t < 5; ++t)
#pragma unroll
            for (int r = 0; r < 16; ++r) { const float e = __builtin_amdgcn_exp2f(P[t][r] - mx); P[t][r] = e; sum += e; }
        sum += xhalf(sum); sum += __builtin_amdgcn_exp2f(sink2 - mx);
        const float inv = 1.f / sum;
        f32x16 O[2];
#pragma unroll
        for (int dh = 0; dh < 2; ++dh) O[dh] = (f32x16){0.f, 0.f, 0.f, 0.f, 0.f, 0.f, 0.f, 0.f, 0.f, 0.f, 0.f, 0.f, 0.f, 0.f, 0.f, 0.f};
#pragma unroll
        for (int t = 0; t < 5; ++t) {
#pragma unroll
            for (int r = 0; r < 16; ++r) P[t][r] *= inv;
#pragma unroll
            for (int s2 = 0; s2 < 2; ++s2) { const bf16x8 pa = pack_acc(P[t], s2);
#pragma unroll
                for (int dh = 0; dh < 2; ++dh) { LAS unsigned char* vb = L + S_V + dh * 16384 + vlane + (32 * (kt0 + t) + 16 * s2) * 64;
                    const s16x4 v0 = ds_tr(vb), v1 = ds_tr(vb + 8 * 64); O[dh] = MFMA32(pa, cat8(v0, v1), O[dh]); } }
        }
#pragma unroll
        for (int dh = 0; dh < 2; ++dh)
#pragma unroll
            for (int r = 0; r < 16; ++r) *(LAS bf16*)(st + crow(r, hi) * 144 + (32 * dh + r32) * 2) = (bf16)f2bf(O[dh][r]);
        asm volatile("s_waitcnt lgkmcnt(0)" ::: "memory");
        const size_t orow = (size_t)b * SEQ + nblk * 128 + t0;
#pragma unroll
        for (int i = 0; i < 4; ++i) { const int rq = i * 8 + (lane >> 3), ch = lane & 7;
            const v4u o = *(const LAS v4u*)(st + rq * 144 + ch * 16);
            GAS v4u* zp = (GAS v4u*)(F.Z + (orow + rq) * 3072 + 1024 + hq * 64 + 8 * ch);
            *zp = mul8b(*zp, o); }
        asm volatile("s_waitcnt lgkmcnt(0)" ::: "memory");
    }
    __syncthreads();
}

constexpr int G_V = 0, G_QD = 36864, G_KN = 54272, G_KDT = 71680, G_ATT = 90112, G_OST = 0, G_WUP = 99328, G_GLR = 107520, G_GSUM = 111616, G_DEC = 115712, G_BG = 116224;
__device__ __forceinline__ void gla_unit(Frame& F, int b, int h) {
    LAS unsigned char* L = F.lds; int tid_ = F.tid; asm volatile("" : "+v"(tid_));
    const int tid = tid_, lane = tid & 63, w = __builtin_amdgcn_readfirstlane(tid >> 6), r32 = lane & 31, hi = lane >> 5;
    for (int i = tid; i < 2048; i += 512) ((LAS float*)(L + G_WUP))[i] = F.w_up[(i >> 7) * 512 + h * 128 + (i & 127)];
    if (tid < 128) ((LAS float*)(L + G_BG))[tid] = F.b_gate[h * 128 + tid];
    f32x16 S[4];
#pragma unroll
    for (int m = 0; m < 4; ++m) S[m] = (f32x16){0.f, 0.f, 0.f, 0.f, 0.f, 0.f, 0.f, 0.f, 0.f, 0.f, 0.f, 0.f, 0.f, 0.f, 0.f, 0.f};
    const int d0 = 2 * lane;
    const int pos0 = (d0 & ~12) | ((d0 & 4) << 1) | ((d0 & 8) >> 1);
    unsigned qreg[8], kreg[8]; v4u vreg[4]; float g0, g1;
    const size_t rowb = (size_t)b * SEQ;
#define GLA_PREFETCH(c_) do { const size_t r0_ = rowb + (size_t)(c_) * 64; \
        _Pragma("unroll") for (int t = 0; t < 8; ++t) { qreg[t] = *(const GAS unsigned*)(F.GQ + (r0_ + 8 * w + t) * 512 + h * 128 + d0); kreg[t] = *(const GAS unsigned*)(F.GK + (r0_ + 8 * w + t) * 512 + h * 128 + d0); } \
        _Pragma("unroll") for (int i = 0; i < 4; ++i) { const int idx = tid + 512 * i; vreg[i] = *(const GAS v4u*)(F.GV + (r0_ + (idx >> 5)) * 1024 + h * 256 + (idx & 31) * 8); } \
        { const float* gp = F.GLR + (r0_ + 8 * w) * 16 + 2 * lane; g0 = gp[0]; g1 = gp[1]; } } while (0)
    GLA_PREFETCH(0);
    const int vlane = (8 * hi + ((lane & 15) >> 2)) * 576 + (32 * w + 16 * ((lane >> 4) & 1) + 4 * (lane & 3)) * 2;
#pragma unroll 1
    for (int c = 0; c < SEQ / 64; ++c) {
        const size_t row0 = rowb + (size_t)c * 64;
        __syncthreads();
        LAS float* glr = (LAS float*)(L + G_GLR) + w * 128;
        glr[2 * lane] = g0; glr[2 * lane + 1] = g1;
#pragma unroll
        for (int i = 0; i < 4; ++i) { const int idx = tid + 512 * i; *(LAS v4u*)(L + G_V + (idx >> 5) * 576 + (idx & 31) * 16) = vreg[i]; }
        asm volatile("s_waitcnt lgkmcnt(0)" ::: "memory");
        float c0[8], c1[8];
        { const LAS float* wup = (const LAS float*)(L + G_WUP) + d0; const float bg0 = ((const LAS float*)(L + G_BG))[d0], bg1 = ((const LAS float*)(L + G_BG))[d0 + 1];
          float run0 = 0.f, run1 = 0.f;
#pragma unroll
          for (int t = 0; t < 8; ++t) { float z0 = bg0, z1 = bg1;
#pragma unroll
            for (int r = 0; r < 16; ++r) { const float gv = glr[t * 16 + r]; z0 += gv * wup[r * 128]; z1 += gv * wup[r * 128 + 1]; }
            const float l0 = fminf(z0, 0.f) - __logf(1.f + __expf(-fabsf(z0))), l1 = fminf(z1, 0.f) - __logf(1.f + __expf(-fabsf(z1)));
            run0 += l0 * 0.0625f; run1 += l1 * 0.0625f; c0[t] = run0; c1[t] = run1; }
          LAS float* gs = (LAS float*)(L + G_GSUM) + w * 128 + d0; gs[0] = run0; gs[1] = run1; }
        __syncthreads();
        { float off0 = 0.f, off1 = 0.f, tot0 = 0.f, tot1 = 0.f;
#pragma unroll
          for (int gI = 0; gI < 8; ++gI) { const LAS float* gs = (const LAS float*)(L + G_GSUM) + gI * 128 + d0; const float a0 = gs[0], a1 = gs[1]; tot0 += a0; tot1 += a1; if (gI < w) { off0 += a0; off1 += a1; } }
          const float el0 = __expf(tot0), el1 = __expf(tot1);
          if (w == 0) { ((LAS float*)(L + G_DEC))[d0] = el0; ((LAS float*)(L + G_DEC))[d0 + 1] = el1; }
          unsigned kd0[4], kd1[4];
#pragma unroll
          for (int t = 0; t < 8; ++t) { const float b0 = off0 + c0[t], b1 = off1 + c1[t];
            const float e0 = __expf(b0), e1 = __expf(b1), n0 = __expf(-b0), n1 = __expf(-b1);
            const float q0 = pg8::bflo(qreg[t]) * 0.08838834764831845f * e0, q1 = pg8::bfhi(qreg[t]) * 0.08838834764831845f * e1;
            const float k0 = pg8::bflo(kreg[t]) * n0, k1 = pg8::bfhi(kreg[t]) * n1;
            *(LAS unsigned*)(L + G_QD + (8 * w + t) * 272 + pos0 * 2) = pg8::cvt_pk_bf16(q0, q1);
            *(LAS unsigned*)(L + G_KN + (8 * w + t) * 272 + pos0 * 2) = pg8::cvt_pk_bf16(k0, k1);
            const unsigned x0 = f2bf(k0 * el0), x1 = f2bf(k1 * el1);
            if (t & 1) { kd0[t >> 1] |= x0 << 16; kd1[t >> 1] |= x1 << 16; } else { kd0[t >> 1] = x0; kd1[t >> 1] = x1; } }
          *(LAS v4u*)(L + G_KDT + d0 * 144 + 16 * w) = (v4u){kd0[0], kd0[1], kd0[2], kd0[3]};
          *(LAS v4u*)(L + G_KDT + (d0 + 1) * 144 + 16 * w) = (v4u){kd1[0], kd1[1], kd1[2], kd1[3]}; }
        __syncthreads();
        if (c + 1 < SEQ / 64) GLA_PREFETCH(c + 1);
#pragma unroll
        for (int tt = 0; tt < 2; ++tt) { const int t16 = 2 * w + tt, ti = t16 >> 2, tj = t16 & 3; f32x4 a4 = (f32x4){0.f, 0.f, 0.f, 0.f};
            if (tj <= ti) {
#pragma unroll
                for (int ks = 0; ks < 4; ++ks) { const bf16x8 ka = *(const LAS bf16x8*)(L + G_KN + (16 * tj + (lane & 15)) * 272 + (32 * ks + 8 * (lane >> 4)) * 2);
                    const bf16x8 qb = *(const LAS bf16x8*)(L + G_QD + (16 * ti + (lane & 15)) * 272 + (32 * ks + 8 * (lane >> 4)) * 2); a4 = MFMA16(ka, qb, a4); }
                const int i_ = 16 * ti + (lane & 15), j_ = 16 * tj + 4 * (lane >> 4);
#pragma unroll
                for (int e = 0; e < 4; ++e) if (j_ + e > i_) a4[e] = 0.f; }
            *(LAS unsigned long long*)(L + G_ATT + (16 * ti + (lane & 15)) * 144 + (16 * tj + 4 * (lane >> 4)) * 2) =
                (unsigned long long)pg8::cvt_pk_bf16(a4[0], a4[1]) | ((unsigned long long)pg8::cvt_pk_bf16(a4[2], a4[3]) << 32); }
        __syncthreads();
        bf16x8 vf[4];
#pragma unroll
        for (int s = 0; s < 4; ++s) { LAS unsigned char* vb = L + G_V + vlane + (16 * s) * 576; vf[s] = cat8(ds_tr(vb), ds_tr(vb + 4 * 576)); }
        f32x16 O[2];
#pragma unroll
        for (int mt = 0; mt < 2; ++mt) {
            O[mt] = (f32x16){0.f, 0.f, 0.f, 0.f, 0.f, 0.f, 0.f, 0.f, 0.f, 0.f, 0.f, 0.f, 0.f, 0.f, 0.f, 0.f};
#pragma unroll
            for (int s = 0; s < 4; ++s) if (s < 2 * mt + 2) { const bf16x8 a = *(const LAS bf16x8*)(L + G_ATT + (32 * mt + r32) * 144 + (16 * s + 8 * hi) * 2); O[mt] = MFMA32(a, vf[s], O[mt]); }
        }
#pragma unroll
        for (int s = 0; s < 8; ++s) { const bf16x8 sfr = pack_acc(S[s >> 1], s & 1);
#pragma unroll
            for (int mt = 0; mt < 2; ++mt) { const bf16x8 a = *(const LAS bf16x8*)(L + G_QD + (32 * mt + r32) * 272 + (16 * s + 8 * hi) * 2); O[mt] = MFMA32(a, sfr, O[mt]); } }
#pragma unroll
        for (int m = 0; m < 4; ++m) {
#pragma unroll
            for (int gI = 0; gI < 4; ++gI) { const f32x4 dv4 = *(const LAS f32x4*)(L + G_DEC + (32 * m + 8 * gI + 4 * hi) * 4);
#pragma unroll
                for (int e = 0; e < 4; ++e) S[m][4 * gI + e] *= dv4[e]; }
#pragma unroll
            for (int s = 0; s < 4; ++s) { const bf16x8 a = *(const LAS bf16x8*)(L + G_KDT + (32 * m + r32) * 144 + (16 * s + 8 * hi) * 2); S[m] = MFMA32(a, vf[s], S[m]); }
        }
        __syncthreads();
#pragma unroll
        for (int mt = 0; mt < 2; ++mt)
#pragma unroll
            for (int r = 0; r < 16; ++r) *(LAS float*)(L + G_OST + (32 * mt + crow(r, hi)) * 1040 + (32 * w + r32) * 4) = O[mt][r];
        __syncthreads();
        { const int tok = tid >> 3, seg = tid & 7; const LAS f32x4* op = (const LAS f32x4*)(L + G_OST + tok * 1040 + seg * 128);
          f32x4 o4[8]; float ss = 0.f;
#pragma unroll
          for (int i = 0; i < 8; ++i) { o4[i] = op[i]; ss += (o4[i][0] * o4[i][0] + o4[i][1] * o4[i][1]) + (o4[i][2] * o4[i][2] + o4[i][3] * o4[i][3]); }
          ss += __shfl_xor(ss, 1); ss += __shfl_xor(ss, 2); ss += __shfl_xor(ss, 4);
          const float rstd = 1.f / sqrtf(ss * (1.f / 256.f) + EPS);
          GAS v4u* zp = (GAS v4u*)(F.Z + (row0 + tok) * 3072 + h * 256 + seg * 32);
#pragma unroll
          for (int i = 0; i < 4; ++i) { const float o8[8] = {o4[2 * i][0] * rstd, o4[2 * i][1] * rstd, o4[2 * i][2] * rstd, o4[2 * i][3] * rstd, o4[2 * i + 1][0] * rstd, o4[2 * i + 1][1] * rstd, o4[2 * i + 1][2] * rstd, o4[2 * i + 1][3] * rstd};
              zp[i] = mul8(zp[i], o8); } }
    }
#undef GLA_PREFETCH
    __syncthreads();
}

struct Args { const float* in[16]; float* out; unsigned char* ws; int ph_lo, ph_hi; };
__global__ void __launch_bounds__(NWAVES * 64, 2) fwd(Args args) {
    extern __shared__ __attribute__((aligned(16))) unsigned char lds_raw[];
    Frame F;
    F.lds = (LAS unsigned char*)lds_raw;
    F.tid = threadIdx.x; F.lane = F.tid & 63; F.wave = __builtin_amdgcn_readfirstlane(F.tid >> 6);
    F.G = gridDim.x; { const int bx = blockIdx.x; F.vcu = (F.G % 8 == 0) ? (bx % 8) * (F.G / 8) + bx / 8 : bx; }
    unsigned char* ws = args.ws; unsigned char* dob = (unsigned char*)args.out;
    F.x = args.in[0]; F.mem = args.in[1]; F.g_mix = args.in[2]; F.g_mem = args.in[3]; F.w_in = args.in[4]; F.b_in = args.in[5]; F.w_up = args.in[6]; F.b_gate = args.in[7];
    F.g_gnorm = args.in[8]; F.sinks = args.in[9]; F.w_mem_kv = args.in[10]; F.w_br_gla = args.in[11]; F.w_br_swa = args.in[12]; F.w_br_mem = args.in[13]; F.w_out = args.in[14]; F.g_final = args.in[15];
    F.out = args.out; F.ctl = (gu32*)(ws + WS_CTL);
    F.WT = (bf16*)(ws + WS_WT); F.WBR = (bf16*)(ws + WS_WBR); F.WOUT = (bf16*)(ws + WS_WOUT); F.RSTD = (float*)(ws + WS_RSTD); F.BIAS = (float*)(ws + WS_BIAS);
    F.COS = (float*)(ws + WS_COS); F.SIN = (float*)(ws + WS_SIN); F.GLR = (float*)(ws + WS_GLR); F.ROWSS = (float*)(ws + WS_CTL + CTL_ROWSS);
    F.Z = (bf16*)(ws + WS_Z); F.GQ = (bf16*)(ws + WS_GQ); F.GK = (bf16*)(ws + WS_GK); F.GV = (bf16*)(ws + WS_GV); F.SQ = (bf16*)(ws + WS_SQ); F.XQ = (bf16*)(ws + WS_XQ);
    F.GATES = (bf16*)(ws + WS_GATES); F.MERGED = (bf16*)(ws + WS_MERGED);
    F.XB = (bf16*)(dob + DO_XB); F.SK = (bf16*)(dob + DO_SK); F.SV = (bf16*)(dob + DO_SV); F.MKV = (bf16*)(dob + DO_MKV);
    volatile LAS unsigned* MISC = (volatile LAS unsigned*)(F.lds + MISC_OFF);
    for (int u = F.tid; u < (LDS_BYTES - MISC_OFF) / 4; u += NWAVES * 64) MISC[u] = 0u;
    __syncthreads();
    XcdBarrier bar; bar.bar = (unsigned*)(F.ctl + CW_BAR); bar.x = 0; bar.st = nullptr;
    if (N_LAUNCHES == 1) bar = xcd_barrier_post((unsigned*)(F.ctl + CW_BAR), MISC + 8);
    const int lo = args.ph_lo, hi = args.ph_hi;
#define IN(k) (lo <= (k) && (k) < hi)
#define SEAM(k) do { if (IN(k) && IN((k) + 1)) xcd_barrier(bar); } while (0)

    if (IN(0)) { p0_prologue(F); SEAM(0); }

    if (IN(1)) {
        pg8::Gemm g{F.XB, F.WT, 1024, 1024, 1024}; pg8::RectOrder S; S.init(T / 256, NT1, 0, TM / 256, NTKV, T / 256, NT1 + NTG, F.G, (int)blockIdx.x);
        pg8::EpiProj E{F.RSTD, F.BIAS, F.GLR, F.GQ, F.GK, F.GV, F.Z, F.SQ, F.SK, F.SV, F.XQ, F.GATES, F.MKV};
        pg8::gemm_phase<pg8::EpiProj, pg8::RectOrder, true, true>(F.lds, g, S, E);
        SEAM(1);
    }

    if (IN(2)) {
        for (;;) {
            if (F.tid == 0) MISC[16] = atomicAdd((unsigned*)(F.ctl + CW_QUEUE), 1u);
            __syncthreads();
            const int u = (int)MISC[16];
            __syncthreads();
            if (u >= 1600) break;
            if (u < 64) {
#if GLA_MFMA
                gla_unit(F, u >> 2, u & 3);
#else
                gla_naive_unit(F, u >> 2, u & 3);
#endif
            } else if (u < 576) { const int i = u - 64;
#if XAT_MFMA
                xat_unit(F, i >> 5, (i >> 3) & 3, i & 7);
#else
                xat_naive_unit(F, i >> 5, (i >> 3) & 3, i & 7);
#endif
            } else { const int i = u - 576;
#if SWA_MFMA
                swa_unit(F, i >> 6, (i >> 2) & 15, i & 3);
#else
                swa_naive_unit(F, i >> 6, (i >> 2) & 15, i & 3);
#endif
            }
        }
        SEAM(2);
    }

    if (IN(3)) {
        pg8::Gemm g{F.XB, F.WT, 1024, 1024, 1024}; pg8::RectOrder S; S.init(T / 256, NTG, NT1, 0, 0, 0, 0, F.G, (int)blockIdx.x);
        pg8::EpiProj E{F.RSTD, F.BIAS, F.GLR, F.GQ, F.GK, F.GV, F.Z, F.SQ, F.SK, F.SV, F.XQ, F.GATES, F.MKV};
        pg8::gemm_phase<pg8::EpiProj, pg8::RectOrder, true, true>(F.lds, g, S, E);
        SEAM(3);
    }

#pragma unroll 1
    for (int j = 0; j < 3; ++j) if (IN(4 + j)) {
        pg8::Gemm g{F.Z + j * 1024, F.WBR + j * 1024, 3072, 3072, 1024}; pg8::RectOrder S; S.init(T / 256, 4, 0, 0, 0, 0, 0, F.G, (int)blockIdx.x);
        pg8::EpiBranch E{F.GATES, F.MERGED, j};
        pg8::gemm_phase<pg8::EpiBranch, pg8::RectOrder, true, true>(F.lds, g, S, E);
        SEAM(4 + j);
    }

    if (IN(7)) {
        pg8::Gemm g{F.MERGED, F.WOUT, 1024, 1024, 1024}; pg8::RectOrder S; S.init(T / 256, 4, 0, 0, 0, 0, 0, F.G, (int)blockIdx.x);
        pg8::EpiOut E{F.x, F.out, F.ROWSS};
        pg8::gemm_phase<pg8::EpiOut, pg8::RectOrder, true, true>(F.lds, g, S, E);
        SEAM(7);
    }

    if (IN(8)) {
        const int gw = F.vcu * NWAVES + F.wave, NGW = F.G * NWAVES;
        for (int m = gw; m < T; m += NGW) {
            const float rstd = 1.f / sqrtf(__hip_atomic_load(F.ROWSS + m, __ATOMIC_RELAXED, __HIP_MEMORY_SCOPE_AGENT) * (1.f / DM) + EPS);
            GAS f32x4* o = (GAS f32x4*)(F.out + (size_t)m * DM) + F.lane; const GAS f32x4* gf = (const GAS f32x4*)F.g_final + F.lane;
#pragma unroll
            for (int j = 0; j < 4; ++j) o[64 * j] = o[64 * j] * rstd * gf[64 * j];
        }
    }
#undef IN
#undef SEAM
}

extern "C" void kernel_launch(void* const* d_in, const int* in_sizes, int n_in, void* d_out, int out_size, void* d_ws, size_t ws_size, hipStream_t stream) {
    static int grid = 0;
    if (grid == 0) {
        if (n_in != 16 || in_sizes[0] != T * DM || out_size != T * DM || ws_size < WS_END) {
            fprintf(stderr, "kernel_launch: unexpected shapes (n_in %d, in0 %d, out %d, ws %zu); nothing launched\n", n_in, n_in > 0 ? in_sizes[0] : -1, out_size, ws_size); grid = -1; return; }
        int dev = 0, cus = 0, per_cu = 0;
        if (hipGetDevice(&dev) != hipSuccess || hipDeviceGetAttribute(&cus, hipDeviceAttributeMultiprocessorCount, dev) != hipSuccess) { grid = -1; return; }
        if (hipFuncSetAttribute((const void*)fwd, hipFuncAttributeMaxDynamicSharedMemorySize, LDS_BYTES) != hipSuccess) { fprintf(stderr, "kernel_launch: hipFuncSetAttribute failed\n"); grid = -1; return; }
        if (hipOccupancyMaxActiveBlocksPerMultiprocessor(&per_cu, (const void*)fwd, NWAVES * 64, LDS_BYTES) != hipSuccess || per_cu < 1) {
            fprintf(stderr, "kernel_launch: occupancy query reports %d workgroups per CU; nothing launched\n", per_cu); (void)hipGetLastError(); grid = -1; return; }
        grid = cus;
    }
    if (grid < 0) return;
    if (hipMemsetAsync((char*)d_ws + WS_CTL, 0, CTL_ZERO_BYTES, stream) != hipSuccess) return;
    Args a{};
    for (int i = 0; i < 16; ++i) a.in[i] = (const float*)d_in[i];
    a.out = (float*)d_out; a.ws = (unsigned char*)d_ws;
    if (N_LAUNCHES == 1) { a.ph_lo = 0; a.ph_hi = N_PHASES; hipLaunchKernelGGL(fwd, dim3(grid), dim3(NWAVES * 64), LDS_BYTES, stream, a); }
    else for (int li = 0; li < N_PHASES; ++li) { a.ph_lo = li; a.ph_hi = li + 1; hipLaunchKernelGGL(fwd, dim3(grid), dim3(NWAVES * 64), LDS_BYTES, stream, a); }
}
```

```cpp
#include <hip/hip_runtime.h>
#include <cstdio>
#include <cstdint>
namespace pg8 {
#define PG8_LAS __attribute__((address_space(3)))
typedef unsigned short bf16_t;
typedef short bf16x8 __attribute__((ext_vector_type(8)));
typedef float f32x4 __attribute__((ext_vector_type(4)));
typedef unsigned u32x4 __attribute__((ext_vector_type(4)));
constexpr int BM = 256, BK = 64, HALF = 128, HTB = HALF * BK * 2  , STAGE_BYTES = 8 * HTB, NXCD = 8, WGM = 8;

__host__ __device__ __forceinline__ int lds_byte(int r, int c) { const int st = (r >> 4) * 2 + (c >> 5), rr = r & 15, cc = c & 31, ob = rr * 64 + cc * 2; return st * 1024 + (ob ^ (((ob >> 9) & 1) << 5)); }
__host__ __device__ __forceinline__ void stage_rc(int b, int& R, int& C) { const int st = b / 1024, sb = b % 1024, swz = sb ^ (((sb >> 9) & 1) << 5); R = (st >> 1) * 16 + swz / 64; C = (st & 1) * 32 + (swz % 64) / 2; }
__host__ __device__ __forceinline__ int perm32(int rho) { const int n = rho >> 4, i = rho & 15; return 8 * (i >> 2) + 4 * n + (i & 3); }

struct Unit { int pm, pn; };
struct Gemm { const bf16_t* A; const bf16_t* Bt; int lda, ldb, K; };


struct RectOrder {
    int nM, nN, pn0, nwg1, nM2, pm2, pn2, nwg, G, c;
    __device__ void init(int nM_, int nN_, int pn0_, int nM2_, int nN2_, int pm2_, int pn2_, int G_, int c_) {
        nM = nM_; nN = nN_; pn0 = pn0_; nwg1 = nM_ * nN_; nM2 = nM2_ > 0 ? nM2_ : 1; pm2 = pm2_; pn2 = pn2_; nwg = nwg1 + nM2_ * nN2_; G = G_; c = c_; }
    __device__ bool next(int i, Unit& u) const {
        const long L = (long)i * G + c; if (L >= nwg) return false;
        if (L < nwg1) {
            int wgid = (int)L; { const int q = nwg1 / NXCD, r = nwg1 % NXCD, xcd = wgid % NXCD, off = wgid / NXCD; wgid = (xcd < r ? xcd * (q + 1) : r * (q + 1) + (xcd - r) * q) + off; }
            const int nig = WGM * nN, gid = wgid / nig, fm = gid * WGM, gsz = (nM - fm) < WGM ? (nM - fm) : WGM;
            u.pm = fm + ((wgid % nig) % gsz); u.pn = pn0 + (wgid % nig) / gsz;
        } else { const int r = (int)L - nwg1; u.pm = pm2 + r % nM2; u.pn = pn2 + r / nM2; }
        return true;
    }
    __device__ __forceinline__ void a_ready(const Unit&) const {}
    __device__ __forceinline__ void done(const Unit&) const {}
};

__device__ __forceinline__ unsigned cvt_pk_bf16(float lo, float hi) { unsigned r; asm volatile("v_cvt_pk_bf16_f32 %0, %1, %2" : "=v"(r) : "v"(lo), "v"(hi)); return r; }
__device__ __forceinline__ float bflo(unsigned w) { return __builtin_bit_cast(float, w << 16); }
__device__ __forceinline__ float bfhi(unsigned w) { return __builtin_bit_cast(float, w & 0xffff0000u); }
__device__ __forceinline__ float sigm(float v) { return __builtin_amdgcn_rcpf(1.f + __expf(-v)); }

struct EpiProj {
    static constexpr bool PERM = true, AFTER_DRAIN = false;
    const float* rstd; const float* bias; float* glr;
    bf16_t *GQ, *GK, *GV, *Z, *SQ, *SK, *SV, *XQ, *GATES, *MKV;
    __device__ __forceinline__ void operator()(const f32x4 (&acc)[2][2][4][2], const Unit& u, int wr, int wc, int fr, int fq) const {
        const int pn = u.pn; bf16_t* base; int ld, ct, act = 0, rowoff = 0;
        if (pn < 2) { base = GQ; ld = 512; ct = pn; }
        else if (pn < 4) { base = GK; ld = 512; ct = pn - 2; }
        else if (pn < 8) { base = GV; ld = 1024; ct = pn - 4; }
        else if (pn < 12) { base = Z; ld = 3072; ct = pn - 8; act = 1; }
        else if (pn < 16) { base = SQ; ld = 1024; ct = pn - 12; }
        else if (pn == 16) { base = SK; ld = 256; ct = 0; }
        else if (pn == 17) { base = SV; ld = 256; ct = 0; }
        else if (pn < 22) { base = Z + 1024; ld = 3072; ct = pn - 18; act = 1; }
        else if (pn < 26) { base = XQ; ld = 1024; ct = pn - 22; }
        else if (pn < 30) { base = Z + 2048; ld = 3072; ct = pn - 26; act = 1; }
        else if (pn == 30) { base = nullptr; ld = 16; ct = 0; act = 3; }
        else if (pn < 43) { base = GATES; ld = 3072; ct = pn - 31; act = 2; }
        else { base = MKV; ld = 2048; ct = pn - 43; rowoff = 32768; }
        const int row0 = u.pm * BM + wr * 64 + fr;
        const int colL = ct * BM + wc * 32 + 8 * fq, bcol0 = pn * BM + wc * 32 + 8 * fq;
        float rs[2][4];
#pragma unroll
        for (int ai = 0; ai < 2; ++ai)
#pragma unroll
            for (int m = 0; m < 4; ++m) rs[ai][m] = rstd[row0 + ai * HALF + m * 16];
        if (act == 3) {
            if (wc == 0 && fq < 2) {
                const f32x4 b0 = *(const f32x4*)(bias + bcol0), b1 = *(const f32x4*)(bias + bcol0 + 4);
#pragma unroll
                for (int ai = 0; ai < 2; ++ai)
#pragma unroll
                    for (int m = 0; m < 4; ++m) { float* rp = glr + (size_t)(row0 + ai * HALF + m * 16) * 16 + 8 * fq;
                        *(f32x4*)rp = acc[ai][0][m][0] * rs[ai][m] + b0; *(f32x4*)(rp + 4) = acc[ai][0][m][1] * rs[ai][m] + b1; }
            }
            return;
        }
        f32x4 bv[2][2];
#pragma unroll
        for (int bj = 0; bj < 2; ++bj)
#pragma unroll
            for (int n = 0; n < 2; ++n) bv[bj][n] = *(const f32x4*)(bias + bcol0 + bj * HALF + 4 * n);
#pragma unroll
        for (int ai = 0; ai < 2; ++ai)
#pragma unroll
            for (int m = 0; m < 4; ++m) { bf16_t* rowp = base + (size_t)(row0 - rowoff + ai * HALF + m * 16) * ld + colL;
#pragma unroll
                for (int bj = 0; bj < 2; ++bj) { f32x4 v0 = acc[ai][bj][m][0] * rs[ai][m] + bv[bj][0], v1 = acc[ai][bj][m][1] * rs[ai][m] + bv[bj][1];
                    if (act == 1) {
#pragma unroll
                        for (int e = 0; e < 4; ++e) { v0[e] = v0[e] * sigm(v0[e]); v1[e] = v1[e] * sigm(v1[e]); } }
                    else if (act == 2) {
#pragma unroll
                        for (int e = 0; e < 4; ++e) { v0[e] = sigm(v0[e]); v1[e] = sigm(v1[e]); } }
                    u32x4 w; w.x = cvt_pk_bf16(v0[0], v0[1]); w.y = cvt_pk_bf16(v0[2], v0[3]); w.z = cvt_pk_bf16(v1[0], v1[1]); w.w = cvt_pk_bf16(v1[2], v1[3]);
                    *(u32x4*)(rowp + bj * HALF) = w; } }
    }
};

struct EpiBranch {
    static constexpr bool PERM = true, AFTER_DRAIN = false;
    const bf16_t* GATES; bf16_t* MERGED; int j;
    __device__ __forceinline__ void operator()(const f32x4 (&acc)[2][2][4][2], const Unit& u, int wr, int wc, int fr, int fq) const {
        const int row0 = u.pm * BM + wr * 64 + fr, col0 = u.pn * BM + wc * 32 + 8 * fq;
#pragma unroll
        for (int ai = 0; ai < 2; ++ai)
#pragma unroll
            for (int m = 0; m < 4; ++m) { const size_t r = (size_t)(row0 + ai * HALF + m * 16);
#pragma unroll
                for (int bj = 0; bj < 2; ++bj) { const int c = col0 + bj * HALF;
                    const u32x4 g = *(const u32x4*)(GATES + r * 3072 + j * 1024 + c);
                    u32x4 o = (u32x4){0u, 0u, 0u, 0u}; if (j > 0) o = *(const u32x4*)(MERGED + r * 1024 + c);
                    const f32x4 a0 = acc[ai][bj][m][0], a1 = acc[ai][bj][m][1];
                    u32x4 w;
                    w.x = cvt_pk_bf16(bflo(o.x) + bflo(g.x) * a0[0], bfhi(o.x) + bfhi(g.x) * a0[1]);
                    w.y = cvt_pk_bf16(bflo(o.y) + bflo(g.y) * a0[2], bfhi(o.y) + bfhi(g.y) * a0[3]);
                    w.z = cvt_pk_bf16(bflo(o.z) + bflo(g.z) * a1[0], bfhi(o.z) + bfhi(g.z) * a1[1]);
                    w.w = cvt_pk_bf16(bflo(o.w) + bflo(g.w) * a1[2], bfhi(o.w) + bfhi(g.w) * a1[3]);
                    *(u32x4*)(MERGED + r * 1024 + c) = w; } }
    }
};

struct EpiOut {
    static constexpr bool PERM = false, AFTER_DRAIN = false;
    const float* x; float* out; float* rowss;
    __device__ __forceinline__ void operator()(const f32x4 (&acc)[2][2][4][2], const Unit& u, int wr, int wc, int fr, int fq) const {
        const int row0 = u.pm * BM + wr * 64 + fr, col0 = u.pn * BM + wc * 32 + 4 * fq;
#pragma unroll
        for (int ai = 0; ai < 2; ++ai)
#pragma unroll
            for (int m = 0; m < 4; ++m) { const size_t r = (size_t)(row0 + ai * HALF + m * 16); float s = 0.f;
#pragma unroll
                for (int bj = 0; bj < 2; ++bj)
#pragma unroll
                    for (int n = 0; n < 2; ++n) { const size_t off = r * 1024 + col0 + bj * HALF + n * 16;
                        const f32x4 y = *(const f32x4*)(x + off) + acc[ai][bj][m][n]; *(f32x4*)(out + off) = y;
                        s += (y[0] * y[0] + y[1] * y[1]) + (y[2] * y[2] + y[3] * y[3]); }
                s += __shfl_xor(s, 16); s += __shfl_xor(s, 32);
                if (fq == 0) atomicAdd(rowss + r, s); }
    }
};

template <class Epi, class Sched, bool ALIGN_EPI = false, bool SP2 = false>
__device__ __forceinline__ void gemm_phase(PG8_LAS unsigned char* lds, const Gemm g, const Sched& S, const Epi& E) {
    const int tid = threadIdx.x, wid = __builtin_amdgcn_readfirstlane(tid >> 6), lane = tid & 63, wr = wid >> 2, wc = wid & 3, fr = lane & 15, fq = lane >> 4;
    const int K = g.K, nt = K / BK;
    unsigned voffA[2], voffB[2];
#pragma unroll
    for (int i = 0; i < 2; ++i) { int R, C; stage_rc(tid * 16 + i * 8192, R, C); const int Rb = Epi::PERM ? ((R & ~31) + perm32(R & 31)) : R;
        voffA[i] = (unsigned)(R * g.lda + C) * 2u; voffB[i] = (unsigned)(Rb * g.ldb + C) * 2u; }
    const size_t kstep = (size_t)(BK * 2);
    const size_t hstepA = (size_t)HALF * g.lda * 2, hstepB = (size_t)HALF * g.ldb * 2;
    const size_t tstepA = 2 * hstepA, tstepB = 2 * hstepB;
    const unsigned ldsw = (unsigned)wid * 1024u;
    const int aoff = lds_byte(wr * 64 + fr, fq * 8), boff = lds_byte(wc * 32 + fr, fq * 8);
#define PG8_SA(b, h) (((b) * 2 + (h)) * HTB)
#define PG8_SB(b, h) ((4 + (b) * 2 + (h)) * HTB)
#define PG8_STAGE(bufoff, gbase, voff) do { _Pragma("unroll") for (int _i = 0; _i < 2; ++_i) \
        __builtin_amdgcn_global_load_lds((const unsigned*)((const char*)(gbase) + (voff)[_i]), (PG8_LAS unsigned*)(lds + (bufoff) + ldsw + _i * 8192), 16, 0, 0); } while (0)
#define PG8_LDA(dst, b, h) do { _Pragma("unroll") for (int m = 0; m < 4; ++m) _Pragma("unroll") for (int k = 0; k < 2; ++k) dst[m][k] = *(const PG8_LAS bf16x8*)(lds + PG8_SA(b, h) + aoff + m * 2048 + k * 1024); } while (0)
#define PG8_LDB(dst, b, h) do { _Pragma("unroll") for (int n = 0; n < 2; ++n) _Pragma("unroll") for (int k = 0; k < 2; ++k) dst[n][k] = *(const PG8_LAS bf16x8*)(lds + PG8_SB(b, h) + boff + n * 2048 + k * 1024); } while (0)
#define PG8_MMA(ai, bj, At, Bt) do { __builtin_amdgcn_s_setprio(1); _Pragma("unroll") for (int m = 0; m < 4; ++m) _Pragma("unroll") for (int n = 0; n < 2; ++n) _Pragma("unroll") for (int k = 0; k < 2; ++k) \
        acc[ai][bj][m][n] = __builtin_amdgcn_mfma_f32_16x16x32_bf16(Bt[n][k], At[m][k], acc[ai][bj][m][n], 0, 0, 0); __builtin_amdgcn_s_setprio(0); } while (0)
#define PG8_WAIT_V(n) asm volatile("s_waitcnt vmcnt(" #n ")" ::: "memory")
#define PG8_WAIT_L(n) asm volatile("s_waitcnt lgkmcnt(" #n ")" ::: "memory")
#define PG8_BAR __builtin_amdgcn_s_barrier()
#define PG8_SCHED __builtin_amdgcn_sched_barrier(0)
    Unit cur, nxt; int ui = 0;
    if (!S.next(0, cur)) return;
    f32x4 acc[2][2][4][2];
#pragma unroll
    for (int a = 0; a < 2; ++a)
#pragma unroll
        for (int b = 0; b < 2; ++b)
#pragma unroll
            for (int m = 0; m < 4; ++m)
#pragma unroll
                for (int n = 0; n < 2; ++n) acc[a][b][m][n] = (f32x4){0.f, 0.f, 0.f, 0.f};
    bf16x8 At[4][2], B0[2][2], B1[2][2];
    const char* cA = (const char*)g.A + (size_t)cur.pm * tstepA; const char* cB = (const char*)g.Bt + (size_t)cur.pn * tstepB;
    S.a_ready(cur);
    if constexpr (SP2) {
        PG8_STAGE(PG8_SB(0, 0), cB, voffB); PG8_STAGE(PG8_SB(0, 1), cB + hstepB, voffB); PG8_STAGE(PG8_SA(0, 0), cA, voffA); PG8_STAGE(PG8_SA(0, 1), cA + hstepA, voffA);
        if (wr == 1) PG8_BAR;
        PG8_WAIT_V(2); PG8_BAR;
        PG8_STAGE(PG8_SB(1, 0), cB + kstep, voffB); PG8_STAGE(PG8_SA(1, 0), cA + kstep, voffA); PG8_STAGE(PG8_SB(1, 1), cB + hstepB + kstep, voffB);
        PG8_WAIT_V(6); PG8_BAR;
    } else {
        PG8_STAGE(PG8_SB(0, 0), cB, voffB); PG8_STAGE(PG8_SA(0, 0), cA, voffA); PG8_STAGE(PG8_SB(0, 1), cB + hstepB, voffB); PG8_STAGE(PG8_SA(0, 1), cA + hstepA, voffA);
        if (wr == 1) PG8_BAR;
        PG8_WAIT_V(4); PG8_BAR;
        PG8_STAGE(PG8_SB(1, 0), cB + kstep, voffB); PG8_STAGE(PG8_SA(1, 0), cA + kstep, voffA); PG8_STAGE(PG8_SB(1, 1), cB + hstepB + kstep, voffB);
        PG8_WAIT_V(6); PG8_BAR;
    }
    for (;;) {
        const bool has_next = S.next(ui + 1, nxt);
        const char* nA = has_next ? (const char*)g.A + (size_t)nxt.pm * tstepA : cA; const char* nB = has_next ? (const char*)g.Bt + (size_t)nxt.pn * tstepB : cB;
        for (int t = 0; t < nt; t += 2) {
            const bool last = (t == nt - 2);
            const char* a1 = cA + (size_t)(t + 1) * kstep;
            const char* a2 = last ? nA : cA + (size_t)(t + 2) * kstep; const char* b2 = last ? nB : cB + (size_t)(t + 2) * kstep;
            const char* a3 = a2 + kstep; const char* b3 = b2 + kstep;
            if (last && has_next) S.a_ready(nxt);
            if constexpr (SP2) {
            PG8_LDB(B0, 0, 0); PG8_LDB(B1, 0, 1); PG8_SCHED; PG8_LDA(At, 0, 0); PG8_STAGE(PG8_SA(1, 1), a1 + hstepA, voffA);
            PG8_WAIT_V(8); PG8_WAIT_L(0); PG8_BAR; PG8_MMA(0, 0, At, B0); PG8_MMA(0, 1, At, B1); PG8_BAR; PG8_SCHED;
            PG8_LDA(At, 0, 1); PG8_STAGE(PG8_SB(0, 0), b2, voffB); PG8_STAGE(PG8_SB(0, 1), b2 + hstepB, voffB); PG8_STAGE(PG8_SA(0, 0), a2, voffA);
            PG8_WAIT_V(8); PG8_WAIT_L(0); PG8_BAR; PG8_MMA(1, 0, At, B0); PG8_MMA(1, 1, At, B1); PG8_BAR; PG8_SCHED;
            PG8_LDB(B0, 1, 0); PG8_LDB(B1, 1, 1); PG8_SCHED; PG8_LDA(At, 1, 0); PG8_STAGE(PG8_SA(0, 1), a2 + hstepA, voffA);
            PG8_WAIT_V(8); PG8_WAIT_L(0); PG8_BAR; PG8_MMA(0, 0, At, B0); PG8_MMA(0, 1, At, B1); PG8_BAR; PG8_SCHED;
            PG8_LDA(At, 1, 1); PG8_STAGE(PG8_SB(1, 0), b3, voffB); PG8_STAGE(PG8_SB(1, 1), b3 + hstepB, voffB); PG8_STAGE(PG8_SA(1, 0), a3, voffA);
            PG8_WAIT_V(8); PG8_WAIT_L(0); PG8_BAR; PG8_MMA(1, 0, At, B0); PG8_MMA(1, 1, At, B1); PG8_BAR; PG8_SCHED;
            } else {
            PG8_LDB(B0, 0, 0); PG8_SCHED; PG8_LDA(At, 0, 0); PG8_STAGE(PG8_SA(1, 1), a1 + hstepA, voffA);
            PG8_WAIT_L(8); PG8_BAR; PG8_WAIT_L(0); PG8_MMA(0, 0, At, B0); PG8_BAR; PG8_SCHED;
            PG8_LDB(B1, 0, 1); PG8_STAGE(PG8_SB(0, 0), b2, voffB);
            PG8_BAR; PG8_WAIT_L(0); PG8_MMA(0, 1, At, B1); PG8_BAR;
            PG8_LDA(At, 0, 1); PG8_STAGE(PG8_SA(0, 0), a2, voffA);
            PG8_BAR; PG8_WAIT_L(0); PG8_MMA(1, 0, At, B0); PG8_BAR; PG8_SCHED;
            PG8_STAGE(PG8_SB(0, 1), b2 + hstepB, voffB);
            PG8_WAIT_V(6); PG8_BAR; PG8_MMA(1, 1, At, B1); PG8_BAR;
            PG8_LDB(B0, 1, 0); PG8_SCHED; PG8_LDA(At, 1, 0); PG8_STAGE(PG8_SA(0, 1), a2 + hstepA, voffA);
            PG8_WAIT_L(8); PG8_BAR; PG8_WAIT_L(0); PG8_MMA(0, 0, At, B0); PG8_BAR; PG8_SCHED;
            PG8_LDB(B1, 1, 1); PG8_STAGE(PG8_SB(1, 0), b3, voffB);
            PG8_BAR; PG8_WAIT_L(0); PG8_MMA(0, 1, At, B1); PG8_BAR;
            PG8_LDA(At, 1, 1); PG8_STAGE(PG8_SA(1, 0), a3, voffA);
            PG8_BAR; PG8_WAIT_L(0); PG8_MMA(1, 0, At, B0); PG8_BAR; PG8_SCHED;
            PG8_STAGE(PG8_SB(1, 1), b3 + hstepB, voffB);
            PG8_WAIT_V(6); PG8_BAR; PG8_MMA(1, 1, At, B1); PG8_BAR;
            }
        }
        if constexpr (ALIGN_EPI) { if (wr == 0) PG8_BAR; }
        if constexpr (!Epi::AFTER_DRAIN) { E(acc, cur, wr, wc, fr, fq); S.done(cur); }
        if (!has_next) break;
#pragma unroll
        for (int a = 0; a < 2; ++a)
#pragma unroll
            for (int b = 0; b < 2; ++b)
#pragma unroll
                for (int m = 0; m < 4; ++m)
#pragma unroll
                    for (int n = 0; n < 2; ++n) acc[a][b][m][n] = (f32x4){0.f, 0.f, 0.f, 0.f};
        cur = nxt; cA = nA; cB = nB; ++ui;
        if constexpr (ALIGN_EPI) { if (wr == 1) PG8_BAR; }
    }
    PG8_WAIT_V(0);
    if constexpr (!ALIGN_EPI) { if (wr == 0) PG8_BAR; }
    PG8_BAR;
    if constexpr (Epi::AFTER_DRAIN) { E.fused(acc, cur, wr, wc, fr, fq, lds, wid, lane); S.done(cur); }
#undef PG8_SA
#undef PG8_SB
#undef PG8_STAGE
#undef PG8_LDA
#undef PG8_LDB
#undef PG8_MMA
#undef PG8_WAIT_V
#undef PG8_WAIT_L
#undef PG8_BAR
#undef PG8_SCHED
}
}
#define GAS __attribute__((address_space(1)))
#define LAS __attribute__((address_space(3)))
typedef unsigned short bf16;
typedef unsigned v4u __attribute__((ext_vector_type(4)));
typedef float f32x4 __attribute__((ext_vector_type(4)));
typedef short bf16x8 __attribute__((ext_vector_type(8)));
typedef GAS unsigned gu32;
typedef GAS unsigned long long gu64;
#define RLX_AGENT __ATOMIC_RELAXED, __HIP_MEMORY_SCOPE_AGENT
#define LDS_WAIT() asm volatile("s_waitcnt lgkmcnt(0)" ::: "memory")
#define VM_WAIT() asm volatile("s_waitcnt vmcnt(0)" ::: "memory")
__device__ __forceinline__ unsigned long long rt() { return __builtin_amdgcn_s_memrealtime(); }
__device__ __forceinline__ unsigned f2bf(float f) { unsigned u = __builtin_bit_cast(unsigned, f); return (u + 0x7fffu + ((u >> 16) & 1u)) >> 16; }
__device__ __forceinline__ unsigned pk2(float lo, float hi) { return f2bf(lo) | (f2bf(hi) << 16); }

#define XB_TMO      128
#define XB_XCNT(j)  (256  + 64 * (j))
#define XB_XSUB(j)  (1280 + 64 * (j))
#define XB_XGEN(j)  (2304 + 64 * (j))
#define XB_TOP      3328
#define XB_TOPGEN   3392
#define XCD_BAR_WORDS 3456
#define XB_SPIN_CAP (1u << 22)

__device__ __forceinline__ unsigned xb_ld(unsigned* p)              { return __hip_atomic_load(p, __ATOMIC_RELAXED, __HIP_MEMORY_SCOPE_AGENT); }
__device__ __forceinline__ unsigned xb_add(unsigned* p, unsigned v) { return __hip_atomic_fetch_add(p, v, __ATOMIC_RELAXED, __HIP_MEMORY_SCOPE_AGENT); }
__device__ __forceinline__ unsigned xb_xcc_id() { return (unsigned)__builtin_amdgcn_s_getreg((3 << 11) | 20) & 0xFu; }
#define XB_SPIN(cond, bar) do { unsigned _sp = 0; while (cond) { __builtin_amdgcn_s_sleep(1); \
    if ((++_sp & 255u) == 0u) { if (xb_ld(&(bar)[XB_TMO])) break; if (_sp > XB_SPIN_CAP) { atomicAdd(&(bar)[XB_TMO], 1u); break; } } } } while (0)

struct XcdBarrier {
    unsigned* bar; unsigned x;
    volatile LAS unsigned* st;
};

__device__ __forceinline__ XcdBarrier xcd_barrier_post(unsigned* bar, volatile LAS unsigned* st) {
    XcdBarrier b; b.bar = bar; b.x = xb_xcc_id(); b.st = st;
    if (threadIdx.x == 0) (void)xb_add(&bar[XB_XCNT(b.x)], 1u);
    return b;
}
__device__ __forceinline__ void xcd_barrier_complete(unsigned* bar, unsigned x, unsigned& nloc, unsigned& nx) {
    const unsigned G = gridDim.x * gridDim.y * gridDim.z;
    unsigned sum, cnt, mine, sp = 0u;
    for (;;) {
        sum = 0u; cnt = 0u; mine = 0u;
#pragma unroll
        for (unsigned j = 0; j < 16; ++j) { const unsigned c = xb_ld(&bar[XB_XCNT(j)]); sum += c; cnt += (c > 0u) ? 1u : 0u; mine = (j == x) ? c : mine; }
        if (sum == G) break;
        __builtin_amdgcn_s_sleep(1);
        if ((++sp & 255u) == 0u) { if (xb_ld(&bar[XB_TMO])) break; if (sp > XB_SPIN_CAP) { atomicAdd(&bar[XB_TMO], 1u); break; } }
    }
    nloc = mine > 0u ? mine : 1u; nx = cnt > 0u ? cnt : 1u;
}

__device__ __forceinline__ void xcd_barrier(const XcdBarrier& b) {
    asm volatile("s_waitcnt vmcnt(0)" ::: "memory");
    __syncthreads();
    if (threadIdx.x == 0) {
        unsigned* bar = b.bar;
        __builtin_amdgcn_s_waitcnt(0);
        unsigned nloc = b.st[0], nx = b.st[1];
        if (nloc == 0u) { xcd_barrier_complete(bar, b.x, nloc, nx); b.st[0] = nloc; b.st[1] = nx; }
        const unsigned old = xb_add(&bar[XB_XSUB(b.x)], 1u);
        const unsigned gen = old / nloc;
        if (old + 1u == (gen + 1u) * nloc) {
            __builtin_amdgcn_fence(__ATOMIC_RELEASE, "agent");
            asm volatile("s_waitcnt vmcnt(0)" ::: "memory");
            const unsigned og = xb_add(&bar[XB_TOP], 1u);
            const unsigned tg = og / nx;
            if (og + 1u == (tg + 1u) * nx) xb_add(&bar[XB_TOPGEN], 1u);
            else XB_SPIN(xb_ld(&bar[XB_TOPGEN]) == tg, bar);
            __builtin_amdgcn_fence(__ATOMIC_ACQUIRE, "agent");
            xb_add(&bar[XB_XGEN(b.x)], 1u);
            asm volatile("s_waitcnt vmcnt(0)" ::: "memory");
        } else {
            XB_SPIN(xb_ld(&bar[XB_XGEN(b.x)]) == gen, bar);
            __builtin_amdgcn_fence(__ATOMIC_ACQUIRE, "agent");
            asm volatile("s_waitcnt vmcnt(0)" ::: "memory");
        }
    }
    __syncthreads();
}

constexpr int NWAVES = 8;
constexpr int BATCH = 16, SEQ = 2048, DM = 1024, T = BATCH * SEQ, MEM = 256, TM = BATCH * MEM;
constexpr int INC = 10768;
constexpr int NT1 = 31, NTG = 12, NTKV = 8;
constexpr int WT_ROWS = (NT1 + NTG + NTKV) * 256;
constexpr float EPS = 1e-6f;
#ifndef GLA_MFMA
#define GLA_MFMA 1
#endif
#ifndef SWA_MFMA
#define SWA_MFMA 1
#endif
#ifndef XAT_MFMA
#define XAT_MFMA 1
#endif
#ifndef PROBE_DUP
#define PROBE_DUP -1
#endif
#ifndef MK_N_LAUNCHES
#define MK_N_LAUNCHES 1
#endif
constexpr int N_PHASES = 9;
constexpr int N_LAUNCHES = MK_N_LAUNCHES;

constexpr size_t MiB = 1u << 20;
constexpr size_t WS_CTL = 0, CTL_ZERO_BYTES = 1 * MiB;
constexpr size_t CTL_ROWSS = 512 * 1024;
constexpr size_t WS_WT = 2 * MiB;
constexpr size_t WS_WBR = 28 * MiB;
constexpr size_t WS_WOUT = 34 * MiB;
constexpr size_t WS_RSTD = 36 * MiB;
constexpr size_t WS_BIAS = 36 * MiB + 256 * 1024;
constexpr size_t WS_COS = 36 * MiB + 512 * 1024, WS_SIN = 36 * MiB + 768 * 1024;
constexpr size_t WS_DEC = 39 * MiB;
constexpr size_t WS_GLR = 37 * MiB;
constexpr size_t WS_Z = 40 * MiB;
constexpr size_t WS_GQ = 232 * MiB, WS_GK = 264 * MiB, WS_GV = 296 * MiB, WS_SQ = 360 * MiB, WS_XQ = 424 * MiB;
constexpr size_t WS_GATES = 232 * MiB, WS_MERGED = 424 * MiB;
constexpr size_t WS_END = 488 * MiB;
constexpr size_t DO_XB = 0, DO_SK = 72 * MiB, DO_SV = 88 * MiB, DO_MKV = 104 * MiB;
constexpr int CW_BAR = 4096, CW_QUEUE = 2048;

constexpr int LDS_BYTES = 159744;
constexpr int MISC_OFF = 158720;

__device__ __forceinline__ float bf2f(bf16 h) { return __builtin_bit_cast(float, (unsigned)h << 16); }
__device__ __forceinline__ float wave_sum(float v) {
#pragma unroll
    for (int o = 1; o < 64; o <<= 1) v += __shfl_xor(v, o);
    return v;
}
__device__ __forceinline__ float wave_max(float v) {
#pragma unroll
    for (int o = 1; o < 64; o <<= 1) v = fmaxf(v, __shfl_xor(v, o));
    return v;
}
__device__ const double INVF[32] = {1.0, 0.7498942093324559, 0.5623413251903491, 0.4216965034285822, 0.31622776601683794, 0.23713737056616552, 0.1778279410038923, 0.1333521432163324, 0.1, 0.07498942093324558,
    0.05623413251903491, 0.042169650342858224, 0.03162277660168379, 0.023713737056616554, 0.01778279410038923, 0.01333521432163324, 0.01, 0.007498942093324558, 0.005623413251903491, 0.004216965034285823,
    0.0031622776601683794, 0.0023713737056616554, 0.0017782794100389228, 0.001333521432163324, 0.001, 0.0007498942093324559, 0.0005623413251903491, 0.00042169650342858224, 0.00031622776601683794,
    0.00023713737056616554, 0.00017782794100389227, 0.0001333521432163324};
__device__ __forceinline__ void sincos_d(double x, float& c, float& s) {
    const double kq = __builtin_rint(x * 0.6366197723675814);
    const double r = (x - kq * 1.5707963267341256) - kq * 6.077094383272197e-11, r2 = r * r;
    const double sr = r + r * r2 * (-1.0 / 6 + r2 * (1.0 / 120 + r2 * (-1.0 / 5040 + r2 * (1.0 / 362880 + r2 * (-1.0 / 39916800 + r2 * (1.0 / 6227020800.0))))));
    const double cr = 1.0 + r2 * (-0.5 + r2 * (1.0 / 24 + r2 * (-1.0 / 720 + r2 * (1.0 / 40320 + r2 * (-1.0 / 3628800 + r2 * (1.0 / 479001600.0))))));
    const int q = (int)kq & 3;
    const double cc = (q == 0) ? cr : (q == 1) ? -sr : (q == 2) ? -cr : sr;
    const double ss = (q == 0) ? sr : (q == 1) ? cr : (q == 2) ? -sr : -cr;
    c = (float)cc; s = (float)ss;
}

template <class T> __device__ __forceinline__ T karg_(int off) { typedef const T __attribute__((address_space(4))) CT; return *(CT*)((const char __attribute__((address_space(4)))*)__builtin_amdgcn_kernarg_segment_ptr() + off); }
#define KARG(T, off) karg_<T>(off)
struct Frame {
    LAS unsigned char* lds; int tid, lane, wave, vcu, G;
    static __device__ __forceinline__ unsigned char* wsb() { return KARG(unsigned char*, 136); }
    static __device__ __forceinline__ float* out() { return KARG(float*, 128); }
    static __device__ __forceinline__ gu32* ctl() { return (gu32*)(wsb() + WS_CTL); }
    static __device__ __forceinline__ const float* x() { return KARG(const float*, 0); }
    static __device__ __forceinline__ const float* mem() { return KARG(const float*, 8); }
    static __device__ __forceinline__ const float* g_mix() { return KARG(const float*, 16); }
    static __device__ __forceinline__ const float* g_mem() { return KARG(const float*, 24); }
    static __device__ __forceinline__ const float* w_in() { return KARG(const float*, 32); }
    static __device__ __forceinline__ const float* b_in() { return KARG(const float*, 40); }
    static __device__ __forceinline__ const float* w_up() { return KARG(const float*, 48); }
    static __device__ __forceinline__ const float* b_gate() { return KARG(const float*, 56); }
    static __device__ __forceinline__ const float* g_gnorm() { return KARG(const float*, 64); }
    static __device__ __forceinline__ const float* sinks() { return KARG(const float*, 72); }
    static __device__ __forceinline__ const float* w_mem_kv() { return KARG(const float*, 80); }
    static __device__ __forceinline__ const float* w_br_gla() { return KARG(const float*, 88); }
    static __device__ __forceinline__ const float* w_br_swa() { return KARG(const float*, 96); }
    static __device__ __forceinline__ const float* w_br_mem() { return KARG(const float*, 104); }
    static __device__ __forceinline__ const float* w_out() { return KARG(const float*, 112); }
    static __device__ __forceinline__ const float* g_final() { return KARG(const float*, 120); }
    static __device__ __forceinline__ bf16* WT() { return (bf16*)(wsb() + WS_WT); }
    static __device__ __forceinline__ bf16* WBR() { return (bf16*)(wsb() + WS_WBR); }
    static __device__ __forceinline__ bf16* WOUT() { return (bf16*)(wsb() + WS_WOUT); }
    static __device__ __forceinline__ float* RSTD() { return (float*)(wsb() + WS_RSTD); }
    static __device__ __forceinline__ float* BIAS() { return (float*)(wsb() + WS_BIAS); }
    static __device__ __forceinline__ float* COS() { return (float*)(wsb() + WS_COS); }
    static __device__ __forceinline__ float* SIN() { return (float*)(wsb() + WS_SIN); }
    static __device__ __forceinline__ float* GLR() { return (float*)(wsb() + WS_GLR); }
    static __device__ __forceinline__ float* ROWSS() { return (float*)(wsb() + WS_CTL + CTL_ROWSS); }
    static __device__ __forceinline__ float* DEC() { return (float*)(wsb() + WS_DEC); }
    static __device__ __forceinline__ bf16* DRY() { return (bf16*)(wsb() + WS_END); }
    static __device__ __forceinline__ bf16* Z() { return (bf16*)(wsb() + WS_Z); }
    static __device__ __forceinline__ bf16* GQ() { return (bf16*)(wsb() + WS_GQ); }
    static __device__ __forceinline__ bf16* GK() { return (bf16*)(wsb() + WS_GK); }
    static __device__ __forceinline__ bf16* GV() { return (bf16*)(wsb() + WS_GV); }
    static __device__ __forceinline__ bf16* SQ() { return (bf16*)(wsb() + WS_SQ); }
    static __device__ __forceinline__ bf16* XQ() { return (bf16*)(wsb() + WS_XQ); }
    static __device__ __forceinline__ bf16* GATES() { return (bf16*)(wsb() + WS_GATES); }
    static __device__ __forceinline__ bf16* MERGED() { return (bf16*)(wsb() + WS_MERGED); }
    static __device__ __forceinline__ bf16* XB() { return (bf16*)((unsigned char*)out() + DO_XB); }
    static __device__ __forceinline__ bf16* SK() { return (bf16*)((unsigned char*)out() + DO_SK); }
    static __device__ __forceinline__ bf16* SV() { return (bf16*)((unsigned char*)out() + DO_SV); }
    static __device__ __forceinline__ bf16* MKV() { return (bf16*)((unsigned char*)out() + DO_MKV); }
};

__device__ __forceinline__ int srccol(int t) { return t < 12 ? t * 256 : t < 30 ? 3088 + (t - 12) * 256 : t == 30 ? 3072 : 7696 + (t - 31) * 256; }
__device__ __forceinline__ void tr_item(const float* W, int ldw, int k0, int scol0, int nvalid, const float* ks, int ksmask, bf16* dst, int ldd, int drow0, int dk0, LAS float* scr, int lane) {
#pragma unroll 8
    for (int i = 0; i < 32; ++i) { const int kk = 2 * i + (lane >> 5), n = lane & 31; float v = 0.f;
        if (n < nvalid) { v = W[(size_t)(k0 + kk) * ldw + scol0 + n]; if (ks) v *= ks[(k0 + kk) & ksmask]; }
        scr[kk * 33 + n] = v; }
    LDS_WAIT(); asm volatile("" ::: "memory");
    const int c = lane & 7;
#pragma unroll
    for (int j = 0; j < 4; ++j) { const int n = (lane >> 3) + 8 * j; const LAS float* s = scr + (8 * c) * 33 + n;
        v4u o; o.x = pk2(s[0 * 33], s[1 * 33]); o.y = pk2(s[2 * 33], s[3 * 33]); o.z = pk2(s[4 * 33], s[5 * 33]); o.w = pk2(s[6 * 33], s[7 * 33]);
        *(GAS v4u*)(dst + (size_t)(drow0 + n) * ldd + dk0 + k0 + 8 * c) = o; }
    LDS_WAIT(); asm volatile("" ::: "memory");
}
__device__ __forceinline__ void p0_prologue(Frame& F) {
    LAS float* scr = (LAS float*)(F.lds + F.wave * 16384);
    const int gw = F.vcu * NWAVES + F.wave, NGW = F.G * NWAVES;
    constexpr int NB_IN = (NT1 + NTG) * 8, NB_KV = 64, NB_BR = 96, NB_OUT = 32, NB = NB_IN + NB_KV + NB_BR + NB_OUT;
    for (int it = gw; it < NB * 16; it += NGW) {
        const int kb = it / NB, nb = it % NB, k0 = kb * 64;
        if (nb < NB_IN) { const int tile = nb >> 3, j = nb & 7; const int nvalid = (tile == 30) ? (j == 0 ? 16 : 0) : 32;
            tr_item(F.w_in(), INC, k0, srccol(tile) + j * 32, nvalid, F.g_mix(), 1023, F.WT(), 1024, nb * 32, 0, scr, F.lane); }
        else if (nb < NB_IN + NB_KV) { const int n0 = (nb - NB_IN) * 32; tr_item(F.w_mem_kv(), 2048, k0, n0, 32, F.g_mem(), 1023, F.WT(), 1024, (NT1 + NTG) * 256 + n0, 0, scr, F.lane); }
        else if (nb < NB_IN + NB_KV + NB_BR) { const int r = nb - NB_IN - NB_KV, s = r >> 5, n0 = (r & 31) * 32;
            if (s == 0) tr_item(F.w_br_gla(), 1024, k0, n0, 32, F.g_gnorm(), 255, F.WBR(), 3072, n0, 0, scr, F.lane);
            else if (s == 1) tr_item(F.w_br_swa(), 1024, k0, n0, 32, nullptr, 255, F.WBR(), 3072, n0, 1024, scr, F.lane);
            else tr_item(F.w_br_mem(), 1024, k0, n0, 32, nullptr, 255, F.WBR(), 3072, n0, 2048, scr, F.lane); }
        else { const int n0 = (nb - NB_IN - NB_KV - NB_BR) * 32; tr_item(F.w_out(), 1024, k0, n0, 32, nullptr, 0, F.WOUT(), 1024, n0, 0, scr, F.lane); }
    }
    for (int m = gw; m < T + TM; m += NGW) {
        const float* src = m < T ? F.x() + (size_t)m * DM : F.mem() + (size_t)(m - T) * DM;
        const GAS f32x4* xr = (const GAS f32x4*)src + F.lane;
        f32x4 v[4]; float s = 0.f;
#pragma unroll
        for (int j = 0; j < 4; ++j) { v[j] = xr[64 * j]; s += (v[j].x * v[j].x + v[j].y * v[j].y) + (v[j].z * v[j].z + v[j].w * v[j].w); }
        const float rstd = 1.f / sqrtf(wave_sum(s) * (1.f / DM) + EPS);
        if (F.lane == 0) F.RSTD()[m] = rstd;
        GAS unsigned long long* o8 = (GAS unsigned long long*)(F.XB() + (size_t)m * DM) + F.lane;
#pragma unroll
        for (int j = 0; j < 4; ++j) o8[64 * j] = (unsigned long long)pk2(v[j].x, v[j].y) | ((unsigned long long)pk2(v[j].z, v[j].w) << 32);
    }
    const int gt = F.vcu * (NWAVES * 64) + F.tid, NGT = F.G * NWAVES * 64;
    for (int i = gt; i < WT_ROWS; i += NGT) { float b = 0.f;
        if (i < (NT1 + NTG) * 256) { const int tile = i >> 8, j = i & 255; if (tile != 30 || j < 16) b = F.b_in()[srccol(tile) + j]; }
        F.BIAS()[i] = b; }
    for (int i = gt; i < SEQ * 32; i += NGT) { float c, s; sincos_d((double)(i >> 5) * INVF[i & 31], c, s); F.COS()[i] = c; F.SIN()[i] = s; }
}

__device__ __forceinline__ void gla_naive_unit(Frame& F, int b, int h) {
    LAS float* sq = (LAS float*)F.lds; LAS float* sk = sq + 8192; LAS float* sa = sk + 8192;
    LAS bf16* sv = (LAS bf16*)(sa + 8192);
    LAS float* sg = (LAS float*)(F.lds + 131072); LAS float* pos = sg + 1024; LAS float* red = pos + 512;
    const int tid = F.tid, dv = tid & 255, dh = tid >> 8;
    float S[64];
#pragma unroll
    for (int i = 0; i < 64; ++i) S[i] = 0.f;
    for (int c = 0; c < SEQ / 64; ++c) {
        const size_t row0 = (size_t)b * SEQ + c * 64;
        for (int i = tid; i < 1024; i += 512) sg[i] = F.GLR()[row0 * 16 + i];
        for (int i = tid; i < 64 * 32; i += 512) { const int tok = i >> 5, c8 = i & 31;
            *(LAS v4u*)(sv + tok * 256 + c8 * 8) = *(const GAS v4u*)(F.GV() + (row0 + tok) * 1024 + h * 256 + c8 * 8); }
        __syncthreads();
        for (int i = tid; i < 8192; i += 512) { const int tok = i >> 7, d = i & 127;
            float z = F.b_gate()[h * 128 + d];
#pragma unroll
            for (int r = 0; r < 16; ++r) z += sg[tok * 16 + r] * F.w_up()[r * 512 + h * 128 + d];
            const float ls = fminf(z, 0.f) - log1pf(expf(-fabsf(z)));
            sa[i] = expf(ls * 0.0625f);
            sq[i] = bf2f(F.GQ()[(row0 + tok) * 512 + h * 128 + d]) * 0.08838834764831845f;
            sk[i] = bf2f(F.GK()[(row0 + tok) * 512 + h * 128 + d]); }
        __syncthreads();
        for (int tok = 0; tok < 64; ++tok) {
            const float vv = bf2f(sv[tok * 256 + dv]); float po = 0.f;
            const LAS float* pa = sa + tok * 128 + dh * 64; const LAS float* pk = sk + tok * 128 + dh * 64; const LAS float* pq = sq + tok * 128 + dh * 64;
#pragma unroll
            for (int i = 0; i < 64; ++i) { S[i] = pa[i] * S[i] + pk[i] * vv; po += pq[i] * S[i]; }
            pos[dh * 256 + dv] = po;
            __syncthreads();
            float o = 0.f;
            if (tid < 256) { o = pos[dv] + pos[256 + dv]; const float ss = wave_sum(o * o); if (F.lane == 0) red[F.wave] = ss; }
            __syncthreads();
            if (tid < 256) { const float tot = (red[0] + red[1]) + (red[2] + red[3]); const float rstd = 1.f / sqrtf(tot * (1.f / 256.f) + EPS);
                bf16* zp = F.Z() + (row0 + tok) * 3072 + h * 256 + dv; *zp = (bf16)f2bf(o * rstd * bf2f(*zp)); }
        }
        __syncthreads();
    }
}
__device__ __forceinline__ void swa_naive_unit(Frame& F, int b, int nblk, int g) {
    LAS float* Ks = (LAS float*)F.lds; LAS float* Vs = Ks + 256 * 65; LAS float* qs = Vs + 256 * 65; LAS float* ps = qs + 512;
    const int tid = F.tid, lane = F.lane, w = F.wave;
    for (int i = tid; i < 256 * 32; i += 512) { const int j = i >> 5, ii = i & 31, kp = (nblk - 1) * 128 + j; float a = 0.f, bb = 0.f;
        if (kp >= 0) { const size_t row = (size_t)b * SEQ + kp; const float x1 = bf2f(F.SK()[row * 256 + g * 64 + ii]), x2 = bf2f(F.SK()[row * 256 + g * 64 + ii + 32]);
            const float c = F.COS()[kp * 32 + ii], s = F.SIN()[kp * 32 + ii]; a = x1 * c - x2 * s; bb = x2 * c + x1 * s; }
        Ks[j * 65 + ii] = a; Ks[j * 65 + ii + 32] = bb; }
    for (int i = tid; i < 256 * 64; i += 512) { const int j = i >> 6, d = i & 63, kp = (nblk - 1) * 128 + j;
        Vs[j * 65 + d] = kp >= 0 ? bf2f(F.SV()[((size_t)b * SEQ + kp) * 256 + g * 64 + d]) : 0.f; }
    __syncthreads();
    const int hq = g * 4 + (w >> 1), tbase = (w & 1) * 64; const float sink = F.sinks()[hq];
    for (int r = 0; r < 64; ++r) {
        const int ti = tbase + r, p = nblk * 128 + ti; const size_t row = (size_t)b * SEQ + p;
        const float xv = bf2f(F.SQ()[row * 1024 + hq * 64 + lane]), pr = __shfl_xor(xv, 32);
        const float c = F.COS()[p * 32 + (lane & 31)], s = F.SIN()[p * 32 + (lane & 31)];
        qs[w * 64 + lane] = lane < 32 ? xv * c - pr * s : xv * c + pr * s;
        asm volatile("s_waitcnt lgkmcnt(0)" ::: "memory");
        float sc[4]; bool valid[4]; float mx = sink;
#pragma unroll
        for (int jj = 0; jj < 4; ++jj) { const int j = lane + 64 * jj, kp = (nblk - 1) * 128 + j; valid[jj] = (kp <= p) && (kp > p - 128) && (kp >= 0);
            float acc = 0.f;
            for (int d = 0; d < 64; ++d) acc += qs[w * 64 + d] * Ks[j * 65 + d];
            sc[jj] = acc * 0.125f; if (valid[jj]) mx = fmaxf(mx, sc[jj]); }
        mx = wave_max(mx);
        float sum = 0.f, pj[4];
#pragma unroll
        for (int jj = 0; jj < 4; ++jj) { pj[jj] = valid[jj] ? __expf(sc[jj] - mx) : 0.f; sum += pj[jj]; }
        sum = wave_sum(sum) + __expf(sink - mx);
        const float inv = 1.f / sum;
#pragma unroll
        for (int jj = 0; jj < 4; ++jj) ps[w * 256 + lane + 64 * jj] = pj[jj] * inv;
        asm volatile("s_waitcnt lgkmcnt(0)" ::: "memory");
        float o = 0.f;
        for (int j = 0; j < 256; ++j) o += ps[w * 256 + j] * Vs[j * 65 + lane];
        bf16* zp = F.Z() + row * 3072 + 1024 + hq * 64 + lane; *zp = (bf16)f2bf(o * bf2f(*zp));
        asm volatile("" ::: "memory");
    }
    __syncthreads();
}
__device__ __forceinline__ void xat_naive_unit(Frame& F, int b, int h, int qb) {
    LAS bf16* Ks = (LAS bf16*)F.lds;
    LAS float* scr = (LAS float*)(F.lds + 132096) + F.wave * 512;
    const int tid = F.tid, lane = F.lane, w = F.wave;
    for (int i = tid; i < 256 * 32; i += 512) { const int m = i >> 5, c8 = i & 31;
        const v4u v = *(const GAS v4u*)(F.MKV() + ((size_t)b * MEM + m) * 2048 + h * 256 + c8 * 8);
        LAS unsigned* d = (LAS unsigned*)(Ks + m * 258 + c8 * 8); d[0] = v.x; d[1] = v.y; d[2] = v.z; d[3] = v.w; }
    __syncthreads();
    for (int it = 0; it < 16; ++it) {
        const size_t row = (size_t)b * SEQ + qb * 256 + w * 32 + it * 2;
#pragma unroll
        for (int rr = 0; rr < 2; ++rr) { const unsigned long long q4 = *(const GAS unsigned long long*)(F.XQ() + (row + rr) * 1024 + h * 256 + lane * 4);
            const unsigned lo = (unsigned)q4, hi = (unsigned)(q4 >> 32);
            scr[rr * 256 + lane * 4 + 0] = pg8::bflo(lo) * 0.0625f; scr[rr * 256 + lane * 4 + 1] = pg8::bfhi(lo) * 0.0625f;
            scr[rr * 256 + lane * 4 + 2] = pg8::bflo(hi) * 0.0625f; scr[rr * 256 + lane * 4 + 3] = pg8::bfhi(hi) * 0.0625f; }
        asm volatile("s_waitcnt lgkmcnt(0)" ::: "memory");
        float acc[2][4];
#pragma unroll
        for (int rr = 0; rr < 2; ++rr)
#pragma unroll
            for (int jj = 0; jj < 4; ++jj) acc[rr][jj] = 0.f;
        for (int d2 = 0; d2 < 128; ++d2) {
            const float q00 = scr[2 * d2], q01 = scr[2 * d2 + 1], q10 = scr[256 + 2 * d2], q11 = scr[256 + 2 * d2 + 1];
#pragma unroll
            for (int jj = 0; jj < 4; ++jj) { const unsigned kw = *(const LAS unsigned*)(Ks + (lane + 64 * jj) * 258 + 2 * d2);
                const float k0 = pg8::bflo(kw), k1 = pg8::bfhi(kw);
                acc[0][jj] += q00 * k0 + q01 * k1; acc[1][jj] += q10 * k0 + q11 * k1; }
        }
        asm volatile("" ::: "memory");
#pragma unroll
        for (int rr = 0; rr < 2; ++rr) {
            float mx = fmaxf(fmaxf(acc[rr][0], acc[rr][1]), fmaxf(acc[rr][2], acc[rr][3])); mx = wave_max(mx);
            float pj[4], sum = 0.f;
#pragma unroll
            for (int jj = 0; jj < 4; ++jj) { pj[jj] = __expf(acc[rr][jj] - mx); sum += pj[jj]; }
            const float inv = 1.f / wave_sum(sum);
#pragma unroll
            for (int jj = 0; jj < 4; ++jj) scr[rr * 256 + lane + 64 * jj] = pj[jj] * inv;
        }
        asm volatile("s_waitcnt lgkmcnt(0)" ::: "memory");
        float o[2][4];
#pragma unroll
        for (int rr = 0; rr < 2; ++rr)
#pragma unroll
            for (int e = 0; e < 4; ++e) o[rr][e] = 0.f;
        const bf16* vb = F.MKV() + (size_t)b * MEM * 2048 + 1024 + h * 256 + lane * 4;
        for (int m = 0; m < 256; ++m) { const unsigned long long v4 = *(const GAS unsigned long long*)(vb + (size_t)m * 2048);
            const unsigned lo = (unsigned)v4, hi = (unsigned)(v4 >> 32); const float v0 = pg8::bflo(lo), v1 = pg8::bfhi(lo), v2 = pg8::bflo(hi), v3 = pg8::bfhi(hi);
            const float p0 = scr[m], p1 = scr[256 + m];
            o[0][0] += p0 * v0; o[0][1] += p0 * v1; o[0][2] += p0 * v2; o[0][3] += p0 * v3;
            o[1][0] += p1 * v0; o[1][1] += p1 * v1; o[1][2] += p1 * v2; o[1][3] += p1 * v3; }
#pragma unroll
        for (int rr = 0; rr < 2; ++rr) { GAS unsigned long long* zp = (GAS unsigned long long*)(F.Z() + (row + rr) * 3072 + 2048 + h * 256 + lane * 4);
            const unsigned long long z4 = *zp; const unsigned lo = (unsigned)z4, hi = (unsigned)(z4 >> 32);
            *zp = (unsigned long long)pk2(o[rr][0] * pg8::bflo(lo), o[rr][1] * pg8::bfhi(lo)) | ((unsigned long long)pk2(o[rr][2] * pg8::bflo(hi), o[rr][3] * pg8::bfhi(hi)) << 32); }
        asm volatile("s_waitcnt lgkmcnt(0)" ::: "memory");
    }
    __syncthreads();
}

typedef short s16x4 __attribute__((ext_vector_type(4)));
typedef float f32x16 __attribute__((ext_vector_type(16)));
#define MFMA32(a, b, c) __builtin_amdgcn_mfma_f32_32x32x16_bf16((a), (b), (c), 0, 0, 0)
#define MFMA16(a, b, c) __builtin_amdgcn_mfma_f32_16x16x32_bf16((a), (b), (c), 0, 0, 0)
__device__ __forceinline__ int crow(int r, int hi) { return (r & 3) + 8 * (r >> 2) + 4 * hi; }
__device__ __forceinline__ s16x4 ds_tr(LAS unsigned char* p) { return __builtin_bit_cast(s16x4, __builtin_amdgcn_ds_read_tr16_b64_v4i16((LAS s16x4*)p)); }
__device__ __forceinline__ bf16x8 cat8(s16x4 a, s16x4 b) { return (bf16x8){a[0], a[1], a[2], a[3], b[0], b[1], b[2], b[3]}; }
__device__ __forceinline__ float xhalf(float v) { return __shfl_xor(v, 32); }
__device__ __forceinline__ bf16x8 pack_acc(const f32x16& p, int s) {
    v4u w; w.x = pg8::cvt_pk_bf16(p[8 * s + 0], p[8 * s + 1]); w.y = pg8::cvt_pk_bf16(p[8 * s + 2], p[8 * s + 3]); w.z = pg8::cvt_pk_bf16(p[8 * s + 4], p[8 * s + 5]); w.w = pg8::cvt_pk_bf16(p[8 * s + 6], p[8 * s + 7]);
    return __builtin_bit_cast(bf16x8, w);
}
__device__ __forceinline__ v4u mul8(v4u z, const float* o) {
    v4u r; r.x = pg8::cvt_pk_bf16(pg8::bflo(z.x) * o[0], pg8::bfhi(z.x) * o[1]); r.y = pg8::cvt_pk_bf16(pg8::bflo(z.y) * o[2], pg8::bfhi(z.y) * o[3]);
    r.z = pg8::cvt_pk_bf16(pg8::bflo(z.z) * o[4], pg8::bfhi(z.z) * o[5]); r.w = pg8::cvt_pk_bf16(pg8::bflo(z.w) * o[6], pg8::bfhi(z.w) * o[7]); return r;
}
__device__ __forceinline__ v4u mul8b(v4u z, v4u o) {
    v4u r; r.x = pg8::cvt_pk_bf16(pg8::bflo(z.x) * pg8::bflo(o.x), pg8::bfhi(z.x) * pg8::bfhi(o.x)); r.y = pg8::cvt_pk_bf16(pg8::bflo(z.y) * pg8::bflo(o.y), pg8::bfhi(z.y) * pg8::bfhi(o.y));
    r.z = pg8::cvt_pk_bf16(pg8::bflo(z.z) * pg8::bflo(o.z), pg8::bfhi(z.z) * pg8::bfhi(o.z)); r.w = pg8::cvt_pk_bf16(pg8::bflo(z.w) * pg8::bflo(o.w), pg8::bfhi(z.w) * pg8::bfhi(o.w)); return r;
}

__device__ __forceinline__ void xat_unit(Frame& F, int b, int h, int qb, bool dry = false) {
    LAS unsigned char* L = F.lds; int tid_ = F.tid; asm volatile("" : "+v"(tid_));
    const int tid = tid_, lane = tid & 63, w = __builtin_amdgcn_readfirstlane(tid >> 6), r32 = lane & 31, hi = lane >> 5;
    const bf16* kvb = F.MKV() + (size_t)b * MEM * 2048 + h * 256;
#pragma unroll 4
    for (int it = 0; it < 16; ++it) { const int idx = tid + 512 * it, m = idx >> 5, c = idx & 31;
        *(LAS v4u*)(L + c * 4096 + m * 16) = *(const GAS v4u*)(kvb + (size_t)m * 2048 + 8 * c); }
    const size_t row = (size_t)b * SEQ + qb * 256 + w * 32 + r32;
    const bf16* qp = F.XQ() + row * 1024 + h * 256 + 8 * hi;
    bf16x8 qa = *(const GAS bf16x8*)qp, qc;
    __syncthreads();
    f32x16 P[8];
#pragma unroll
    for (int kt = 0; kt < 8; ++kt) P[kt] = (f32x16){0.f, 0.f, 0.f, 0.f, 0.f, 0.f, 0.f, 0.f, 0.f, 0.f, 0.f, 0.f, 0.f, 0.f, 0.f, 0.f};
#pragma unroll 1
    for (int s = 0; s < 16; s += 2) {
        qc = *(const GAS bf16x8*)(qp + 16 * (s + 1));
        { LAS unsigned char* kb = L + (2 * s + hi) * 4096 + r32 * 16;
#pragma unroll
          for (int kt = 0; kt < 8; ++kt) { const bf16x8 a = *(const LAS bf16x8*)(kb + kt * 512); P[kt] = MFMA32(a, qa, P[kt]); } }
        if (s + 2 < 16) qa = *(const GAS bf16x8*)(qp + 16 * (s + 2));
        { LAS unsigned char* kb = L + (2 * s + 2 + hi) * 4096 + r32 * 16;
#pragma unroll
          for (int kt = 0; kt < 8; ++kt) { const bf16x8 a = *(const LAS bf16x8*)(kb + kt * 512); P[kt] = MFMA32(a, qc, P[kt]); } }
    }
    constexpr float C2 = 0.0625f * 1.4426950408889634f;
    float mx = P[0][0];
#pragma unroll
    for (int kt = 0; kt < 8; ++kt)
#pragma unroll
        for (int r = 0; r < 16; ++r) mx = fmaxf(mx, P[kt][r]);
    mx = fmaxf(mx, xhalf(mx));
    const float mc = mx * C2; float sum = 0.f;
#pragma unroll
    for (int kt = 0; kt < 8; ++kt)
#pragma unroll
        for (int r = 0; r < 16; ++r) { const float e = __builtin_amdgcn_exp2f(P[kt][r] * C2 - mc); P[kt][r] = e; sum += e; }
    sum += xhalf(sum);
    const float inv = 1.f / sum;
    bf16x8 pf[8][2];
#pragma unroll
    for (int kt = 0; kt < 8; ++kt) {
#pragma unroll
        for (int r = 0; r < 16; ++r) P[kt][r] *= inv;
        pf[kt][0] = pack_acc(P[kt], 0); pf[kt][1] = pack_acc(P[kt], 1); }
    __syncthreads();
#pragma unroll 4
    for (int it = 0; it < 16; ++it) { const int idx = tid + 512 * it, m = idx >> 5, c = idx & 31;
        *(LAS v4u*)(L + (c >> 2) * 16384 + m * 64 + (c & 3) * 16) = *(const GAS v4u*)(kvb + 1024 + (size_t)m * 2048 + 8 * c); }
    __syncthreads();
    LAS unsigned char* st = L + 131072 + w * 2560;
    const int vlane = (4 * hi + ((lane & 15) >> 2)) * 64 + ((lane >> 4) & 1) * 32 + (lane & 3) * 8;
    const size_t orow = (size_t)b * SEQ + qb * 256 + w * 32;
#pragma unroll 1
    for (int dt = 0; dt < 8; ++dt) {
        f32x16 O = (f32x16){0.f, 0.f, 0.f, 0.f, 0.f, 0.f, 0.f, 0.f, 0.f, 0.f, 0.f, 0.f, 0.f, 0.f, 0.f, 0.f};
        LAS unsigned char* vb = L + dt * 16384 + vlane;
#pragma unroll
        for (int kt = 0; kt < 8; ++kt)
#pragma unroll
            for (int s2 = 0; s2 < 2; ++s2) { const s16x4 v0 = ds_tr(vb + (32 * kt + 16 * s2) * 64), v1 = ds_tr(vb + (32 * kt + 16 * s2 + 8) * 64); O = MFMA32(pf[kt][s2], cat8(v0, v1), O); }
#pragma unroll
        for (int r = 0; r < 16; ++r) *(LAS bf16*)(st + crow(r, hi) * 80 + r32 * 2) = (bf16)f2bf(O[r]);
        asm volatile("s_waitcnt lgkmcnt(0)" ::: "memory");
#pragma unroll
        for (int i = 0; i < 2; ++i) { const int rq = i * 16 + (lane >> 2), ch = lane & 3;
            const v4u o = *(const LAS v4u*)(st + rq * 80 + ch * 16);
            const size_t zi = (orow + rq) * 3072 + 2048 + h * 256 + 32 * dt + 8 * ch; GAS v4u* zp = (GAS v4u*)(F.Z() + zi);
            const v4u zn = mul8b(*zp, o); if (dry) zp = (GAS v4u*)(F.DRY() + (zi & 0x7ffff8)); *zp = zn; }
        asm volatile("s_waitcnt lgkmcnt(0)" ::: "memory");
    }
    __syncthreads();
}

__device__ __forceinline__ void swa_unit(Frame& F, int b, int nblk, int g, bool dry = false) {
    LAS unsigned char* L = F.lds; int tid_ = F.tid; asm volatile("" : "+v"(tid_));
    const int tid = tid_, lane = tid & 63, w = __builtin_amdgcn_readfirstlane(tid >> 6), r32 = lane & 31, hi = lane >> 5;
    constexpr int S_V = 32768, S_ST = 65536;
#pragma unroll
    for (int it = 0; it < 2; ++it) { const int idx = tid + 512 * it, j = idx >> 2, c = idx & 3, kp = (nblk - 1) * 128 + j;
        v4u o1 = (v4u){0u, 0u, 0u, 0u}, o2 = o1;
        if (kp >= 0) { const bf16* kr = F.SK() + ((size_t)b * SEQ + kp) * 256 + g * 64 + 8 * c;
            const v4u x1 = *(const GAS v4u*)kr, x2 = *(const GAS v4u*)(kr + 32);
            const f32x4 c0 = *(const GAS f32x4*)(F.COS() + kp * 32 + 8 * c), c1 = *(const GAS f32x4*)(F.COS() + kp * 32 + 8 * c + 4);
            const f32x4 s0 = *(const GAS f32x4*)(F.SIN() + kp * 32 + 8 * c), s1 = *(const GAS f32x4*)(F.SIN() + kp * 32 + 8 * c + 4);
            const float a[8] = {pg8::bflo(x1.x), pg8::bfhi(x1.x), pg8::bflo(x1.y), pg8::bfhi(x1.y), pg8::bflo(x1.z), pg8::bfhi(x1.z), pg8::bflo(x1.w), pg8::bfhi(x1.w)};
            const float bb[8] = {pg8::bflo(x2.x), pg8::bfhi(x2.x), pg8::bflo(x2.y), pg8::bfhi(x2.y), pg8::bflo(x2.z), pg8::bfhi(x2.z), pg8::bflo(x2.w), pg8::bfhi(x2.w)};
            const float cs[8] = {c0[0], c0[1], c0[2], c0[3], c1[0], c1[1], c1[2], c1[3]}, sn[8] = {s0[0], s0[1], s0[2], s0[3], s1[0], s1[1], s1[2], s1[3]};
            o1.x = pg8::cvt_pk_bf16(a[0] * cs[0] - bb[0] * sn[0], a[1] * cs[1] - bb[1] * sn[1]); o1.y = pg8::cvt_pk_bf16(a[2] * cs[2] - bb[2] * sn[2], a[3] * cs[3] - bb[3] * sn[3]);
            o1.z = pg8::cvt_pk_bf16(a[4] * cs[4] - bb[4] * sn[4], a[5] * cs[5] - bb[5] * sn[5]); o1.w = pg8::cvt_pk_bf16(a[6] * cs[6] - bb[6] * sn[6], a[7] * cs[7] - bb[7] * sn[7]);
            o2.x = pg8::cvt_pk_bf16(bb[0] * cs[0] + a[0] * sn[0], bb[1] * cs[1] + a[1] * sn[1]); o2.y = pg8::cvt_pk_bf16(bb[2] * cs[2] + a[2] * sn[2], bb[3] * cs[3] + a[3] * sn[3]);
            o2.z = pg8::cvt_pk_bf16(bb[4] * cs[4] + a[4] * sn[4], bb[5] * cs[5] + a[5] * sn[5]); o2.w = pg8::cvt_pk_bf16(bb[6] * cs[6] + a[6] * sn[6], bb[7] * cs[7] + a[7] * sn[7]); }
        *(LAS v4u*)(L + c * 4096 + j * 16) = o1; *(LAS v4u*)(L + (c + 4) * 4096 + j * 16) = o2; }
#pragma unroll
    for (int it = 0; it < 4; ++it) { const int idx = tid + 512 * it, j = idx >> 3, c = idx & 7, kp = (nblk - 1) * 128 + j;
        v4u v = (v4u){0u, 0u, 0u, 0u}; if (kp >= 0) v = *(const GAS v4u*)(F.SV() + ((size_t)b * SEQ + kp) * 256 + g * 64 + 8 * c);
        *(LAS v4u*)(L + S_V + (c >> 2) * 16384 + j * 64 + (c & 3) * 16) = v; }
    __syncthreads();
    const int hq = g * 4 + (w >> 1), th = w & 1;
    constexpr float LOG2E = 1.4426950408889634f, QS = 0.125f * LOG2E;
    const float sink2 = F.sinks()[hq] * LOG2E;
    LAS unsigned char* st = L + S_ST + w * 4608;
    const int vlane = (4 * hi + ((lane & 15) >> 2)) * 64 + ((lane >> 4) & 1) * 32 + (lane & 3) * 8;
#pragma unroll 1
    for (int rb = 0; rb < 2; ++rb) {
        const int t0 = th * 64 + rb * 32, p = nblk * 128 + t0 + r32; const size_t row = (size_t)b * SEQ + p;
        bf16x8 qf[4];
        { v4u x[4];
#pragma unroll
          for (int s = 0; s < 4; ++s) x[s] = *(const GAS v4u*)(F.SQ() + row * 1024 + hq * 64 + 16 * s + 8 * hi);
#pragma unroll
          for (int s = 0; s < 2; ++s) {
            const f32x4 c0 = *(const GAS f32x4*)(F.COS() + p * 32 + 16 * s + 8 * hi), c1 = *(const GAS f32x4*)(F.COS() + p * 32 + 16 * s + 8 * hi + 4);
            const f32x4 s0 = *(const GAS f32x4*)(F.SIN() + p * 32 + 16 * s + 8 * hi), s1 = *(const GAS f32x4*)(F.SIN() + p * 32 + 16 * s + 8 * hi + 4);
            const v4u x1 = x[s], x2 = x[s + 2];
            const float a[8] = {pg8::bflo(x1.x), pg8::bfhi(x1.x), pg8::bflo(x1.y), pg8::bfhi(x1.y), pg8::bflo(x1.z), pg8::bfhi(x1.z), pg8::bflo(x1.w), pg8::bfhi(x1.w)};
            const float bb[8] = {pg8::bflo(x2.x), pg8::bfhi(x2.x), pg8::bflo(x2.y), pg8::bfhi(x2.y), pg8::bflo(x2.z), pg8::bfhi(x2.z), pg8::bflo(x2.w), pg8::bfhi(x2.w)};
            const float cs[8] = {c0[0] * QS, c0[1] * QS, c0[2] * QS, c0[3] * QS, c1[0] * QS, c1[1] * QS, c1[2] * QS, c1[3] * QS};
            const float sn[8] = {s0[0] * QS, s0[1] * QS, s0[2] * QS, s0[3] * QS, s1[0] * QS, s1[1] * QS, s1[2] * QS, s1[3] * QS};
            v4u o1, o2;
            o1.x = pg8::cvt_pk_bf16(a[0] * cs[0] - bb[0] * sn[0], a[1] * cs[1] - bb[1] * sn[1]); o1.y = pg8::cvt_pk_bf16(a[2] * cs[2] - bb[2] * sn[2], a[3] * cs[3] - bb[3] * sn[3]);
            o1.z = pg8::cvt_pk_bf16(a[4] * cs[4] - bb[4] * sn[4], a[5] * cs[5] - bb[5] * sn[5]); o1.w = pg8::cvt_pk_bf16(a[6] * cs[6] - bb[6] * sn[6], a[7] * cs[7] - bb[7] * sn[7]);
            o2.x = pg8::cvt_pk_bf16(bb[0] * cs[0] + a[0] * sn[0], bb[1] * cs[1] + a[1] * sn[1]); o2.y = pg8::cvt_pk_bf16(bb[2] * cs[2] + a[2] * sn[2], bb[3] * cs[3] + a[3] * sn[3]);
            o2.z = pg8::cvt_pk_bf16(bb[4] * cs[4] + a[4] * sn[4], bb[5] * cs[5] + a[5] * sn[5]); o2.w = pg8::cvt_pk_bf16(bb[6] * cs[6] + a[6] * sn[6], bb[7] * cs[7] + a[7] * sn[7]);
            qf[s] = __builtin_bit_cast(bf16x8, o1); qf[s + 2] = __builtin_bit_cast(bf16x8, o2); } }
        const int kt0 = t0 >> 5;
        f32x16 P[5];
#pragma unroll
        for (int t = 0; t < 5; ++t) {
            P[t] = (f32x16){0.f, 0.f, 0.f, 0.f, 0.f, 0.f, 0.f, 0.f, 0.f, 0.f, 0.f, 0.f, 0.f, 0.f, 0.f, 0.f};
#pragma unroll
            for (int s = 0; s < 4; ++s) { const bf16x8 a = *(const LAS bf16x8*)(L + (2 * s + hi) * 4096 + (32 * (kt0 + t) + r32) * 16); P[t] = MFMA32(a, qf[s], P[t]); }
        }
        const float NEG = -INFINITY;
#pragma unroll
        for (int r = 0; r < 16; ++r) { const int kr = crow(r, hi); if (!(kr > r32)) P[0][r] = NEG; if (!(kr <= r32)) P[4][r] = NEG; }
        if (nblk == 0) {
#pragma unroll
            for (int t = 0; t < 4; ++t) if (kt0 + t < 4) {
#pragma unroll
                for (int r = 0; r < 16; ++r) P[t][r] = NEG; }
        }
        float mx = sink2;
#pragma unroll
        for (int t = 0; t < 5; ++t)
#pragma unroll
            for (int r = 0; r < 16; ++r) mx = fmaxf(mx, P[t][r]);
        mx = fmaxf(mx, xhalf(mx));
        float sum = 0.f;
#pragma unroll
        for (int t = 0; t < 5; ++t)
#pragma unroll
            for (int r = 0; r < 16; ++r) { const float e = __builtin_amdgcn_exp2f(P[t][r] - mx); P[t][r] = e; sum += e; }
        sum += xhalf(sum); sum += __builtin_amdgcn_exp2f(sink2 - mx);
        const float inv = 1.f / sum;
        f32x16 O[2];
#pragma unroll
        for (int dh = 0; dh < 2; ++dh) O[dh] = (f32x16){0.f, 0.f, 0.f, 0.f, 0.f, 0.f, 0.f, 0.f, 0.f, 0.f, 0.f, 0.f, 0.f, 0.f, 0.f, 0.f};
#pragma unroll
        for (int t = 0; t < 5; ++t) {
#pragma unroll
            for (int r = 0; r < 16; ++r) P[t][r] *= inv;
#pragma unroll
            for (int s2 = 0; s2 < 2; ++s2) { const bf16x8 pa = pack_acc(P[t], s2);
#pragma unroll
                for (int dh = 0; dh < 2; ++dh) { LAS unsigned char* vb = L + S_V + dh * 16384 + vlane + (32 * (kt0 + t) + 16 * s2) * 64;
                    const s16x4 v0 = ds_tr(vb), v1 = ds_tr(vb + 8 * 64); O[dh] = MFMA32(pa, cat8(v0, v1), O[dh]); } }
        }
#pragma unroll
        for (int dh = 0; dh < 2; ++dh)
#pragma unroll
            for (int r = 0; r < 16; ++r) *(LAS bf16*)(st + crow(r, hi) * 144 + (32 * dh + r32) * 2) = (bf16)f2bf(O[dh][r]);
        asm volatile("s_waitcnt lgkmcnt(0)" ::: "memory");
        const size_t orow = (size_t)b * SEQ + nblk * 128 + t0;
#pragma unroll
        for (int i = 0; i < 4; ++i) { const int rq = i * 8 + (lane >> 3), ch = lane & 7;
            const v4u o = *(const LAS v4u*)(st + rq * 144 + ch * 16);
            const size_t zi = (orow + rq) * 3072 + 1024 + hq * 64 + 8 * ch; GAS v4u* zp = (GAS v4u*)(F.Z() + zi);
            const v4u zn = mul8b(*zp, o); if (dry) zp = (GAS v4u*)(F.DRY() + (zi & 0x7ffff8)); *zp = zn; }
        asm volatile("s_waitcnt lgkmcnt(0)" ::: "memory");
    }
    __syncthreads();
}

__device__ __forceinline__ void gla_prep_unit(Frame& F, int b, int c) {
    LAS unsigned char* L = F.lds; int tid_ = F.tid; asm volatile("" : "+v"(tid_));
    const int tid = tid_;
    LAS float* glr = (LAS float*)L;
    const size_t row0 = (size_t)b * SEQ + (size_t)c * 64;
    __syncthreads();
    for (int i = tid; i < 1024; i += 512) glr[i] = F.GLR()[row0 * 16 + i];
    float wu[16];
#pragma unroll
    for (int r = 0; r < 16; ++r) wu[r] = F.w_up()[r * 512 + tid];
    const float bg = F.b_gate()[tid];
    __syncthreads();
    float run = 0.f;
    bf16* qp = F.GQ() + row0 * 512 + tid; bf16* kp = F.GK() + row0 * 512 + tid;
#pragma unroll 8
    for (int t = 0; t < 64; ++t) {
        float z = bg;
#pragma unroll
        for (int r4 = 0; r4 < 4; ++r4) { const f32x4 g4 = *(const LAS f32x4*)(glr + t * 16 + 4 * r4); z += g4[0] * wu[4 * r4] + g4[1] * wu[4 * r4 + 1] + g4[2] * wu[4 * r4 + 2] + g4[3] * wu[4 * r4 + 3]; }
        const float ls = fminf(z, 0.f) - __logf(1.f + __expf(-fabsf(z)));
        run += ls * 0.0625f;
        const float e = __expf(run), n = __expf(-run);
        const float q = bf2f(qp[(size_t)t * 512]) * 0.08838834764831845f * e, k = bf2f(kp[(size_t)t * 512]) * n;
        qp[(size_t)t * 512] = (bf16)f2bf(q); kp[(size_t)t * 512] = (bf16)f2bf(k);
    }
    F.DEC()[((size_t)b * 32 + c) * 512 + tid] = __expf(run);
}

#define GBAR() asm volatile("s_waitcnt lgkmcnt(0)\n\ts_barrier" ::: "memory")
constexpr int G_V = 0, G_QD = 36864, G_KN = 54272, G_ATT = 71680, G_DEC = 80896, G_SS = 81408, G_ST = 83456;
__device__ __forceinline__ void gla_unit(Frame& F, int b, int h, bool dry = false) {
    LAS unsigned char* L = F.lds; int tid_ = F.tid; asm volatile("" : "+v"(tid_));
    const int tid = tid_, lane = tid & 63, w = __builtin_amdgcn_readfirstlane(tid >> 6), r32 = lane & 31, hi = lane >> 5;
    f32x16 S[4];
#pragma unroll
    for (int m = 0; m < 4; ++m) S[m] = (f32x16){0.f, 0.f, 0.f, 0.f, 0.f, 0.f, 0.f, 0.f, 0.f, 0.f, 0.f, 0.f, 0.f, 0.f, 0.f, 0.f};
    v4u qreg[2], kreg[2], vreg[4], zreg[4]; float dreg = 0.f;
    const size_t rowb = (size_t)b * SEQ;
    const int erow = lane >> 2, eseg = lane & 3;
#define GLA_PREFETCH(c_) do { const size_t r0_ = rowb + (size_t)(c_) * 64; \
        _Pragma("unroll") for (int i = 0; i < 2; ++i) { const int idx = tid + 512 * i; qreg[i] = *(const GAS v4u*)(F.GQ() + (r0_ + (idx >> 4)) * 512 + h * 128 + (idx & 15) * 8); \
                                                         kreg[i] = *(const GAS v4u*)(F.GK() + (r0_ + (idx >> 4)) * 512 + h * 128 + (idx & 15) * 8); } \
        _Pragma("unroll") for (int i = 0; i < 4; ++i) { const int idx = tid + 512 * i; vreg[i] = *(const GAS v4u*)(F.GV() + (r0_ + (idx >> 5)) * 1024 + h * 256 + (idx & 31) * 8); } \
        if (tid < 128) dreg = F.DEC()[((size_t)b * 32 + (c_)) * 512 + h * 128 + tid]; \
        } while (0)
#define GLA_PREFETCH_Z(c_) do { const size_t r0_ = rowb + (size_t)(c_) * 64; \
        _Pragma("unroll") for (int i = 0; i < 4; ++i) zreg[i] = *(const GAS v4u*)(F.Z() + (r0_ + erow + 16 * i) * 3072 + h * 256 + 32 * w + 8 * eseg); } while (0)
    GLA_PREFETCH(0);
    const int vlane = (8 * hi + ((lane & 15) >> 2)) * 576 + (32 * w + 16 * ((lane >> 4) & 1) + 4 * (lane & 3)) * 2;
    const int klane = (8 * hi + ((lane & 15) >> 2)) * 272 + (16 * ((lane >> 4) & 1) + 4 * (lane & 3)) * 2;
    LAS unsigned char* st = L + G_ST + w * 9216;
    GBAR();
#pragma unroll 1
    for (int c = 0; c < SEQ / 64; ++c) {
        const size_t row0 = rowb + (size_t)c * 64;
#pragma unroll
        for (int i = 0; i < 2; ++i) { const int idx = tid + 512 * i, row = idx >> 4, u = idx & 15;
            LAS unsigned char* qd = L + G_QD + row * 272 + 32 * (u >> 1) + 8 * (u & 1);
            *(LAS unsigned long long*)qd = (unsigned long long)qreg[i].x | ((unsigned long long)qreg[i].y << 32);
            *(LAS unsigned long long*)(qd + 16) = (unsigned long long)qreg[i].z | ((unsigned long long)qreg[i].w << 32);
            *(LAS v4u*)(L + G_KN + row * 272 + u * 16) = kreg[i]; }
#pragma unroll
        for (int i = 0; i < 4; ++i) { const int idx = tid + 512 * i; *(LAS v4u*)(L + G_V + (idx >> 5) * 576 + (idx & 31) * 16) = vreg[i]; }
        if (tid < 128) ((LAS float*)(L + G_DEC))[tid] = dreg;
        GBAR();
#pragma unroll
        for (int tt = 0; tt < 2; ++tt) { const int t16 = 2 * w + tt, ti = t16 >> 2, tj = t16 & 3; f32x4 a4 = (f32x4){0.f, 0.f, 0.f, 0.f};
            if (tj <= ti) { const int q4 = lane >> 4;
#pragma unroll
                for (int ks = 0; ks < 4; ++ks) {
                    const LAS unsigned char* kp = L + G_KN + (16 * tj + (lane & 15)) * 272 + (32 * ks + 16 * (q4 >> 1) + 4 * (q4 & 1)) * 2;
                    const unsigned long long k0 = *(const LAS unsigned long long*)kp, k1 = *(const LAS unsigned long long*)(kp + 16);
                    const bf16x8 ka = __builtin_bit_cast(bf16x8, (v4u){(unsigned)k0, (unsigned)(k0 >> 32), (unsigned)k1, (unsigned)(k1 >> 32)});
                    const bf16x8 qb = *(const LAS bf16x8*)(L + G_QD + (16 * ti + (lane & 15)) * 272 + (32 * ks + 8 * q4) * 2); a4 = MFMA16(ka, qb, a4); }
                const int i_ = 16 * ti + (lane & 15), j_ = 16 * tj + 4 * q4;
#pragma unroll
                for (int e = 0; e < 4; ++e) if (j_ + e > i_) a4[e] = 0.f; }
            *(LAS unsigned long long*)(L + G_ATT + (16 * ti + (lane & 15)) * 144 + (16 * tj + 4 * (lane >> 4)) * 2) =
                (unsigned long long)pg8::cvt_pk_bf16(a4[0], a4[1]) | ((unsigned long long)pg8::cvt_pk_bf16(a4[2], a4[3]) << 32); }
        GBAR();
        GLA_PREFETCH_Z(c);
        bf16x8 vf[4];
#pragma unroll
        for (int s = 0; s < 4; ++s) { LAS unsigned char* vb = L + G_V + vlane + (16 * s) * 576; vf[s] = cat8(ds_tr(vb), ds_tr(vb + 4 * 576)); }
        __builtin_amdgcn_sched_barrier(0);
        f32x16 O[2];
#pragma unroll
        for (int mt = 0; mt < 2; ++mt) {
            O[mt] = (f32x16){0.f, 0.f, 0.f, 0.f, 0.f, 0.f, 0.f, 0.f, 0.f, 0.f, 0.f, 0.f, 0.f, 0.f, 0.f, 0.f};
#pragma unroll
            for (int s = 0; s < 4; ++s) if (s < 2 * mt + 2) { const bf16x8 a = *(const LAS bf16x8*)(L + G_ATT + (32 * mt + r32) * 144 + (16 * s + 8 * hi) * 2); O[mt] = MFMA32(a, vf[s], O[mt]); }
        }
#pragma unroll
        for (int s = 0; s < 8; ++s) { if ((s & 1) == 0) __builtin_amdgcn_sched_barrier(0);
            const bf16x8 sfr = pack_acc(S[s >> 1], s & 1);
#pragma unroll
            for (int mt = 0; mt < 2; ++mt) { const bf16x8 a = *(const LAS bf16x8*)(L + G_QD + (32 * mt + r32) * 272 + (16 * s + 8 * hi) * 2); O[mt] = MFMA32(a, sfr, O[mt]); } }
#pragma unroll
        for (int mt = 0; mt < 2; ++mt)
#pragma unroll
            for (int r = 0; r < 16; ++r) *(LAS float*)(st + (32 * mt + crow(r, hi)) * 144 + r32 * 4) = O[mt][r];
        __builtin_amdgcn_sched_barrier(0);
        if (c + 1 < SEQ / 64) GLA_PREFETCH(c + 1);
#pragma unroll
        for (int m = 0; m < 4; ++m) {
            __builtin_amdgcn_sched_barrier(0);
#pragma unroll
            for (int s = 0; s < 4; ++s) { LAS unsigned char* kb = L + G_KN + klane + (16 * s) * 272 + (32 * m) * 2; S[m] = MFMA32(cat8(ds_tr(kb), ds_tr(kb + 4 * 272)), vf[s], S[m]); }
#pragma unroll
            for (int gI = 0; gI < 4; ++gI) { const f32x4 dv4 = *(const LAS f32x4*)(L + G_DEC + (32 * m + 8 * gI + 4 * hi) * 4);
#pragma unroll
                for (int e = 0; e < 4; ++e) S[m][4 * gI + e] *= dv4[e]; }
        }
        __builtin_amdgcn_sched_barrier(0);
        asm volatile("s_waitcnt lgkmcnt(0)" ::: "memory");
#pragma unroll
        for (int i = 0; i < 4; ++i) { const LAS f32x4* op = (const LAS f32x4*)(st + (erow + 16 * i) * 144 + eseg * 32); const f32x4 a = op[0], bq = op[1];
            float ss = ((a[0] * a[0] + a[1] * a[1]) + (a[2] * a[2] + a[3] * a[3])) + ((bq[0] * bq[0] + bq[1] * bq[1]) + (bq[2] * bq[2] + bq[3] * bq[3]));
            ss += __shfl_xor(ss, 1); ss += __shfl_xor(ss, 2);
            if (eseg == 0) ((LAS float*)(L + G_SS))[(erow + 16 * i) * 8 + w] = ss; }
        GBAR();
#pragma unroll
        for (int i = 0; i < 4; ++i) { const LAS f32x4* sp = (const LAS f32x4*)(L + G_SS + (erow + 16 * i) * 32); const f32x4 s0 = sp[0], s1 = sp[1];
            const LAS f32x4* op = (const LAS f32x4*)(st + (erow + 16 * i) * 144 + eseg * 32); const f32x4 a = op[0], bq = op[1];
            const float tot = ((s0[0] + s0[1]) + (s0[2] + s0[3])) + ((s1[0] + s1[1]) + (s1[2] + s1[3]));
            const float rstd = 1.f / sqrtf(tot * (1.f / 256.f) + EPS);
            const float o8[8] = {a[0] * rstd, a[1] * rstd, a[2] * rstd, a[3] * rstd, bq[0] * rstd, bq[1] * rstd, bq[2] * rstd, bq[3] * rstd};
            const size_t zi = (row0 + erow + 16 * i) * 3072 + h * 256 + 32 * w + 8 * eseg;
            GAS v4u* zp = dry ? (GAS v4u*)(F.DRY() + (zi & 0x7ffff8)) : (GAS v4u*)(F.Z() + zi);
            *zp = mul8(zreg[i], o8); }
    }
#undef GLA_PREFETCH
#undef GLA_PREFETCH_Z
    __syncthreads();
}

struct Args { const float* in[16]; float* out; unsigned char* ws; int ph_lo, ph_hi; };
static_assert(sizeof(Args) == 152, "Args layout");
__global__ void __launch_bounds__(NWAVES * 64, 2) fwd(Args args) {
    extern __shared__ __attribute__((aligned(16))) unsigned char lds_raw[];
    Frame F;
    F.lds = (LAS unsigned char*)lds_raw;
    F.tid = threadIdx.x; F.lane = F.tid & 63; F.wave = __builtin_amdgcn_readfirstlane(F.tid >> 6);
    F.G = gridDim.x; { const int bx = blockIdx.x; F.vcu = (F.G % 8 == 0) ? (bx % 8) * (F.G / 8) + bx / 8 : bx; }
    volatile LAS unsigned* MISC = (volatile LAS unsigned*)(F.lds + MISC_OFF);
    for (int u = F.tid; u < (LDS_BYTES - MISC_OFF) / 4; u += NWAVES * 64) MISC[u] = 0u;
    __syncthreads();
    XcdBarrier bar; bar.bar = (unsigned*)(F.ctl() + CW_BAR); bar.x = 0; bar.st = nullptr;
    if (N_LAUNCHES == 1) bar = xcd_barrier_post((unsigned*)(F.ctl() + CW_BAR), MISC + 8);
    const int lo = args.ph_lo, hi = args.ph_hi;
#define IN(k) (lo <= (k) && (k) < hi)
#define SEAM(k) do { if (IN(k) && IN((k) + 1)) xcd_barrier(bar); } while (0)

    if (IN(0)) { for (int rep = 0; rep < (PROBE_DUP == 0 ? 2 : 1); ++rep) { if (rep) xcd_barrier(bar); p0_prologue(F); } SEAM(0); }

    if (IN(1)) {
        pg8::Gemm g{F.XB(), F.WT(), 1024, 1024, 1024}; pg8::RectOrder S; S.init(T / 256, NT1, 0, TM / 256, NTKV, T / 256, NT1 + NTG, F.G, (int)blockIdx.x);
        pg8::EpiProj E{F.RSTD(), F.BIAS(), F.GLR(), F.GQ(), F.GK(), F.GV(), F.Z(), F.SQ(), F.SK(), F.SV(), F.XQ(), F.GATES(), F.MKV()};
        pg8::gemm_phase<pg8::EpiProj, pg8::RectOrder, true, true>(F.lds, g, S, E);
        SEAM(1);
    }

#if PROBE_DUP == 1
    if (IN(1)) {
        pg8::Gemm g{F.XB(), F.WT(), 1024, 1024, 1024}; pg8::RectOrder S; S.init(T / 256, NT1, 0, TM / 256, NTKV, T / 256, NT1 + NTG, F.G, (int)blockIdx.x);
        pg8::EpiProj E{F.RSTD(), F.BIAS(), F.GLR(), F.GQ(), F.GK(), F.GV(), F.Z(), F.SQ(), F.SK(), F.SV(), F.XQ(), F.GATES(), F.MKV()};
        pg8::gemm_phase<pg8::EpiProj, pg8::RectOrder, true, true>(F.lds, g, S, E);
        SEAM(1);
    }

#endif
    if (IN(2)) {
        for (int u = blockIdx.x; u < BATCH * 32; u += F.G) gla_prep_unit(F, u >> 5, u & 31);
        xcd_barrier(bar);
    }
    if (IN(2)) {
        for (;;) {
            if (F.tid == 0) MISC[16] = atomicAdd((unsigned*)(F.ctl() + CW_QUEUE), 1u);
            __syncthreads();
            const int u = (int)MISC[16];
            __syncthreads();
            if (u >= 1600) break;
            if (u < 64) {
#if GLA_MFMA
                if (PROBE_DUP == 20) gla_unit(F, u >> 2, u & 3, true);
                gla_unit(F, u >> 2, u & 3);
#else
                gla_naive_unit(F, u >> 2, u & 3);
#endif
            } else if (u < 576) { const int i = u - 64;
#if XAT_MFMA
                if (PROBE_DUP == 21) xat_unit(F, i >> 5, (i >> 3) & 3, i & 7, true);
                xat_unit(F, i >> 5, (i >> 3) & 3, i & 7);
#else
                xat_naive_unit(F, i >> 5, (i >> 3) & 3, i & 7);
#endif
            } else { const int i = u - 576;
#if SWA_MFMA
                if (PROBE_DUP == 22) swa_unit(F, i >> 6, (i >> 2) & 15, i & 3, true);
                swa_unit(F, i >> 6, (i >> 2) & 15, i & 3);
#else
                swa_naive_unit(F, i >> 6, (i >> 2) & 15, i & 3);
#endif
            }
        }
        SEAM(2);
    }

    if (IN(3)) {
        pg8::Gemm g{F.XB(), F.WT(), 1024, 1024, 1024}; pg8::RectOrder S; S.init(T / 256, NTG, NT1, 0, 0, 0, 0, F.G, (int)blockIdx.x);
        pg8::EpiProj E{F.RSTD(), F.BIAS(), F.GLR(), F.GQ(), F.GK(), F.GV(), F.Z(), F.SQ(), F.SK(), F.SV(), F.XQ(), F.GATES(), F.MKV()};
        pg8::gemm_phase<pg8::EpiProj, pg8::RectOrder, true, true>(F.lds, g, S, E);
        SEAM(3);
    }

#if PROBE_DUP == 3
    if (IN(3)) {
        pg8::Gemm g{F.XB(), F.WT(), 1024, 1024, 1024}; pg8::RectOrder S; S.init(T / 256, NTG, NT1, 0, 0, 0, 0, F.G, (int)blockIdx.x);
        pg8::EpiProj E{F.RSTD(), F.BIAS(), F.GLR(), F.GQ(), F.GK(), F.GV(), F.Z(), F.SQ(), F.SK(), F.SV(), F.XQ(), F.GATES(), F.MKV()};
        pg8::gemm_phase<pg8::EpiProj, pg8::RectOrder, true, true>(F.lds, g, S, E);
        SEAM(3);
    }

#endif
#pragma unroll 1
    for (int jj = 0; jj < (PROBE_DUP == 4 ? 6 : 3); ++jj) if (IN(4 + jj % 3)) { const int j = jj % 3;
        if (jj == 3) xcd_barrier(bar);
        pg8::Gemm g{F.Z() + j * 1024, F.WBR() + j * 1024, 3072, 3072, 1024}; pg8::RectOrder S; S.init(T / 256, 4, 0, 0, 0, 0, 0, F.G, (int)blockIdx.x);
        pg8::EpiBranch E{F.GATES(), F.MERGED(), j};
        pg8::gemm_phase<pg8::EpiBranch, pg8::RectOrder, true, true>(F.lds, g, S, E);
        if (jj >= (PROBE_DUP == 4 ? 3 : 0)) SEAM(4 + j); else xcd_barrier(bar);
    }

    if (IN(7)) {
        pg8::Gemm g{F.MERGED(), F.WOUT(), 1024, 1024, 1024}; pg8::RectOrder S; S.init(T / 256, 4, 0, 0, 0, 0, 0, F.G, (int)blockIdx.x);
        pg8::EpiOut E{F.x(), F.out(), F.ROWSS()};
        pg8::gemm_phase<pg8::EpiOut, pg8::RectOrder, true, true>(F.lds, g, S, E);
        SEAM(7);
    }

    if (IN(8)) {
        const int gw = F.vcu * NWAVES + F.wave, NGW = F.G * NWAVES;
        for (int m = gw; m < T; m += NGW) {
            const float rstd = 1.f / sqrtf(__hip_atomic_load(F.ROWSS() + m, __ATOMIC_RELAXED, __HIP_MEMORY_SCOPE_AGENT) * (1.f / DM) + EPS);
            GAS f32x4* o = (GAS f32x4*)(F.out() + (size_t)m * DM) + F.lane; const GAS f32x4* gf = (const GAS f32x4*)F.g_final() + F.lane;
#pragma unroll
            for (int j = 0; j < 4; ++j) o[64 * j] = o[64 * j] * rstd * gf[64 * j];
        }
    }
#undef IN
#undef SEAM
}

extern "C" void kernel_launch(void* const* d_in, const int* in_sizes, int n_in, void* d_out, int out_size, void* d_ws, size_t ws_size, hipStream_t stream) {
    static int grid = 0;
    if (grid == 0) {
        if (n_in != 16 || in_sizes[0] != T * DM || out_size != T * DM || ws_size < WS_END) {
            fprintf(stderr, "kernel_launch: unexpected shapes (n_in %d, in0 %d, out %d, ws %zu); nothing launched\n", n_in, n_in > 0 ? in_sizes[0] : -1, out_size, ws_size); grid = -1; return; }
        int dev = 0, cus = 0, per_cu = 0;
        if (hipGetDevice(&dev) != hipSuccess || hipDeviceGetAttribute(&cus, hipDeviceAttributeMultiprocessorCount, dev) != hipSuccess) { grid = -1; return; }
        if (hipFuncSetAttribute((const void*)fwd, hipFuncAttributeMaxDynamicSharedMemorySize, LDS_BYTES) != hipSuccess) { fprintf(stderr, "kernel_launch: hipFuncSetAttribute failed\n"); grid = -1; return; }
        if (hipOccupancyMaxActiveBlocksPerMultiprocessor(&per_cu, (const void*)fwd, NWAVES * 64, LDS_BYTES) != hipSuccess || per_cu < 1) {
            fprintf(stderr, "kernel_launch: occupancy query reports %d workgroups per CU; nothing launched\n", per_cu); (void)hipGetLastError(); grid = -1; return; }
        grid = cus;
    }
    if (grid < 0) return;
    if (hipMemsetAsync((char*)d_ws + WS_CTL, 0, CTL_ZERO_BYTES, stream) != hipSuccess) return;
    Args a{};
    for (int i = 0; i < 16; ++i) a.in[i] = (const float*)d_in[i];
    a.out = (float*)d_out; a.ws = (unsigned char*)d_ws;
    if (N_LAUNCHES == 1) { a.ph_lo = 0; a.ph_hi = N_PHASES; hipLaunchKernelGGL(fwd, dim3(grid), dim3(NWAVES * 64), LDS_BYTES, stream, a); }
    else for (int li = 0; li < N_PHASES; ++li) { a.ph_lo = li; a.ph_hi = li + 1; hipLaunchKernelGGL(fwd, dim3(grid), dim3(NWAVES * 64), LDS_BYTES, stream, a); }
}
```
